# Optimizing an MI355X kernel written in HIP

```python
import jax, jax.numpy as jnp
from jax import lax
import numpy as np

D_MODEL = 2048
BATCH = 4
SEQ = 4096
DEPTH = 2

GRID_W = 64
CTX_LEN = 256
ROPE_BASE = 10000.0
NORM_EPS = 1e-6
NEG_INF = -1e30

SWA_HEADS = 8
SWA_KV_HEADS = 2
SWA_HEAD_DIM = 128
SWA_WINDOW = 128
SWA_BLOCK = 128

MLA_HEADS = 8
MLA_Q_RANK = 512
MLA_KV_RANK = 256
MLA_NOPE_DIM = 128
MLA_ROPE_DIM = 64
MLA_V_DIM = 128
MLA_Q_BLOCK = 128

_AB_SIZES = (SWA_HEADS * SWA_HEAD_DIM, SWA_KV_HEADS * SWA_HEAD_DIM, SWA_KV_HEADS * SWA_HEAD_DIM,
             MLA_Q_RANK, MLA_KV_RANK, MLA_ROPE_DIM)
AB_IN = sum(_AB_SIZES)
AB_SPLITS = tuple(int(s) for s in np.cumsum(_AB_SIZES)[:-1])
AB_OUT = SWA_HEADS * SWA_HEAD_DIM + MLA_HEADS * MLA_V_DIM

RET_HEADS = 8
RET_QK_DIM = D_MODEL // RET_HEADS
RET_V_DIM = 2 * RET_QK_DIM
RET_CHUNK = 128
_RET_SIZES = (RET_HEADS * RET_QK_DIM, RET_HEADS * RET_QK_DIM, RET_HEADS * RET_V_DIM, RET_HEADS * RET_V_DIM)
RET_IN = sum(_RET_SIZES)
RET_SPLITS = tuple(int(s) for s in np.cumsum(_RET_SIZES)[:-1])
RET_OUT = RET_HEADS * RET_V_DIM

FFN_HIDDEN = ((8 * D_MODEL + 3 * 256 - 1) // (3 * 256)) * 256

N_AB = (DEPTH + 1) // 2
N_RET = DEPTH // 2

kernel_name = "hybrid_swa_mla_retention_prefix_dit"


def _rmsnorm(x, g):
    x32 = x.astype(jnp.float32)
    y = x32 * lax.rsqrt(jnp.mean(x32 * x32, axis=-1, keepdims=True) + NORM_EPS)
    return (y * g.astype(jnp.float32)).astype(x.dtype)


def _modulation(cond, w, b):
    return jnp.split(jax.nn.silu(cond) @ w + b, 6, axis=-1)


def _axial_rope_tables(row, col, rot_dim, dtype):
    n_freq = rot_dim // 4
    inv = ROPE_BASE ** (-jnp.arange(n_freq, dtype=jnp.float32) / n_freq)
    ang = jnp.concatenate([row[:, None] * inv, col[:, None] * inv], axis=-1)
    return jnp.cos(ang).astype(dtype), jnp.sin(ang).astype(dtype)


def _apply_rope(x, cos, sin):
    x1, x2 = jnp.split(x, 2, axis=-1)
    c = cos[None, :, None, :]
    s = sin[None, :, None, :]
    return jnp.concatenate([x1 * c - x2 * s, x1 * s + x2 * c], axis=-1)


def _swa_sink_attention(q, k, v, q_c, k_c, v_c, sink):
    B, S, H, d = q.shape
    KV = k.shape[2]
    G = H // KV
    Cn = k_c.shape[1]
    W = SWA_BLOCK
    nb = S // W
    scale = d ** -0.5
    sink_g = sink.reshape(KV, G).astype(jnp.float32)

    qc = q_c.reshape(B, Cn, KV, G, d)
    s_cc = jnp.einsum('bikgd,bjkd->bkgij', qc, k_c).astype(jnp.float32) * scale
    s_cc = jnp.concatenate([s_cc, jnp.broadcast_to(sink_g[None, :, :, None, None], s_cc.shape[:-1] + (1,))], axis=-1)
    p_cc = jax.nn.softmax(s_cc, axis=-1)[..., :Cn].astype(v_c.dtype)
    o_c = jnp.einsum('bkgij,bjkd->bikgd', p_cc, v_c).reshape(B, Cn, H, d)

    pad = ((0, 0), (W, W), (0, 0), (0, 0))
    kp = jnp.pad(k, pad).reshape(B, nb + 2, W, KV, d)
    vp = jnp.pad(v, pad).reshape(B, nb + 2, W, KV, d)
    kb = jnp.concatenate([kp[:, :-2], kp[:, 1:-1], kp[:, 2:]], axis=2)
    vb = jnp.concatenate([vp[:, :-2], vp[:, 1:-1], vp[:, 2:]], axis=2)
    qb = q.reshape(B, nb, W, KV, G, d)
    s_band = jnp.einsum('bnikgd,bnjkd->bnkgij', qb, kb).astype(jnp.float32) * scale
    qi = jnp.arange(W)
    kj = jnp.arange(3 * W)
    blk = jnp.arange(nb)
    rel = kj[None, :] - W - qi[:, None]
    kpos = blk[:, None] * W - W + kj[None, :]
    valid = (jnp.abs(rel) <= SWA_WINDOW)[None] & ((kpos >= 0) & (kpos < S))[:, None, :]
    s_band = jnp.where(valid[None, :, None, None], s_band, NEG_INF)
    s_lc = jnp.einsum('bnikgd,bjkd->bnkgij', qb, k_c).astype(jnp.float32) * scale
    sink_b = jnp.broadcast_to(sink_g[None, None, :, :, None, None], s_band.shape[:-1] + (1,))
    p = jax.nn.softmax(jnp.concatenate([s_band, s_lc, sink_b], axis=-1), axis=-1)
    p_band = p[..., :3 * W].astype(v.dtype)
    p_lc = p[..., 3 * W:3 * W + Cn].astype(v.dtype)
    o = jnp.einsum('bnkgij,bnjkd->bnikgd', p_band, vb) + jnp.einsum('bnkgij,bjkd->bnikgd', p_lc, v_c)
    return o.reshape(B, S, H, d), o_c


def _mla_attend(q_nope, q_rope, k_nope, k_rope, v):
    scale = (MLA_NOPE_DIM + MLA_ROPE_DIM) ** -0.5
    s = (jnp.einsum('bihd,bjhd->bhij', q_nope, k_nope)
         + jnp.einsum('bihd,bjd->bhij', q_rope, k_rope)).astype(jnp.float32) * scale
    p = jax.nn.softmax(s, axis=-1).astype(v.dtype)
    return jnp.einsum('bhij,bjhd->bihd', p, v)


def _ab_mixer(h, hc, w_in, w_out, sink, q_norm_g, w_q_b, kv_norm_g, w_kv_b, cos_a, sin_a, cos_b, sin_b):
    def project(z):
        B, L, _ = z.shape
        qa, ka, va, q_lat, kv_lat, k_r = jnp.split(z @ w_in, AB_SPLITS, axis=-1)
        qa = qa.reshape(B, L, SWA_HEADS, SWA_HEAD_DIM)
        ka = ka.reshape(B, L, SWA_KV_HEADS, SWA_HEAD_DIM)
        va = va.reshape(B, L, SWA_KV_HEADS, SWA_HEAD_DIM)
        qm = (_rmsnorm(q_lat, q_norm_g) @ w_q_b).reshape(B, L, MLA_HEADS, MLA_NOPE_DIM + MLA_ROPE_DIM)
        kvm = (_rmsnorm(kv_lat, kv_norm_g) @ w_kv_b).reshape(B, L, MLA_HEADS, MLA_NOPE_DIM + MLA_V_DIM)
        return (qa, ka, va, qm[..., :MLA_NOPE_DIM], qm[..., MLA_NOPE_DIM:],
                kvm[..., :MLA_NOPE_DIM], k_r, kvm[..., MLA_NOPE_DIM:])

    B, S, _ = h.shape
    qa, ka, va, qn, qr, kn, kr, vm = project(h)
    qa = _apply_rope(qa, cos_a, sin_a)
    ka = _apply_rope(ka, cos_a, sin_a)
    qr = _apply_rope(qr, cos_b, sin_b)
    kr = _apply_rope(kr[:, :, None, :], cos_b, sin_b)[:, :, 0, :]
    qa_c, ka_c, va_c, qn_c, qr_c, kn_c, kr_c, vm_c = project(hc)

    oa, oa_c = _swa_sink_attention(qa, ka, va, qa_c, ka_c, va_c, sink)

    ob_c = _mla_attend(qn_c, qr_c, kn_c, kr_c, vm_c)
    kn_all = jnp.concatenate([kn_c, kn], axis=1)
    kr_all = jnp.concatenate([kr_c, kr], axis=1)
    v_all = jnp.concatenate([vm_c, vm], axis=1)
    nb = S // MLA_Q_BLOCK
    qn_b = qn.reshape(B, nb, MLA_Q_BLOCK, MLA_HEADS, MLA_NOPE_DIM).swapaxes(0, 1)
    qr_b = qr.reshape(B, nb, MLA_Q_BLOCK, MLA_HEADS, MLA_ROPE_DIM).swapaxes(0, 1)
    ob = lax.map(lambda qq: _mla_attend(qq[0], qq[1], kn_all, kr_all, v_all), (qn_b, qr_b))
    ob = ob.swapaxes(0, 1).reshape(B, S, MLA_HEADS * MLA_V_DIM)

    Cn = hc.shape[1]
    out = jnp.concatenate([oa.reshape(B, S, -1), ob], axis=-1) @ w_out
    out_c = jnp.concatenate([oa_c.reshape(B, Cn, -1), ob_c.reshape(B, Cn, -1)], axis=-1) @ w_out
    return out, out_c


def _retention_scan(q, k, v, log_g, s0):
    B, L, H, _ = q.shape
    dv = v.shape[-1]
    C = RET_CHUNK
    n = L // C
    pos = jnp.arange(C, dtype=jnp.float32)
    diff = pos[:, None] - pos[None, :]
    lg = log_g.astype(jnp.float32)
    d_intra = jnp.where(diff[None] >= 0, jnp.exp(lg[:, None, None] * jnp.maximum(diff, 0.0)[None]), 0.0)
    q_dec = jnp.exp(lg[:, None] * (pos + 1.0)[None])[..., None]
    k_dec = jnp.exp(lg[:, None] * (C - 1.0 - pos)[None])[..., None]
    c_dec = jnp.exp(lg * C)[:, None, None]

    def chunks(z):
        return z.astype(jnp.float32).reshape(B, n, C, H, z.shape[-1]).transpose(1, 0, 3, 2, 4)

    def step(s, qkv):
        qi, ki, vi = qkv
        a = jnp.einsum('bhid,bhjd->bhij', qi, ki) * d_intra
        o = jnp.einsum('bhij,bhjv->bhiv', a, vi) + jnp.einsum('bhid,bhdv->bhiv', qi * q_dec, s)
        s = s * c_dec + jnp.einsum('bhjd,bhjv->bhdv', ki * k_dec, vi)
        return s, o

    s_fin, o = lax.scan(step, s0, (chunks(q), chunks(k), chunks(v)))
    o = o.transpose(1, 0, 3, 2, 4).reshape(B, L, H, dv)
    return o.astype(v.dtype), s_fin


def _retention_mixer(h, hc, w_in, logit_f, logit_b, gn_g, w_out, cos_r, sin_r):
    H, dk, dv = RET_HEADS, RET_QK_DIM, RET_V_DIM

    def project(z):
        B, L, _ = z.shape
        q, k, v, g = jnp.split(z @ w_in, RET_SPLITS, axis=-1)
        return q.reshape(B, L, H, dk), k.reshape(B, L, H, dk) * (dk ** -0.5), v.reshape(B, L, H, dv), g

    q, k, v, g = project(h)
    q = _apply_rope(q, cos_r, sin_r)
    k = _apply_rope(k, cos_r, sin_r)
    qc, kc, vc, gc = project(hc)
    lg_f = jax.nn.log_sigmoid(logit_f.astype(jnp.float32))
    lg_b = jax.nn.log_sigmoid(logit_b.astype(jnp.float32))
    s0 = jnp.zeros((h.shape[0], H, dk, dv), jnp.float32)

    def flip(z):
        return jnp.flip(z, axis=1)

    oc_f, s_f = _retention_scan(qc, kc, vc, lg_f, s0)
    oc_b, s_b = _retention_scan(flip(qc), flip(kc), flip(vc), lg_b, s0)
    o_f, _ = _retention_scan(q, k, v, lg_f, s_f)
    o_b, _ = _retention_scan(flip(q), flip(k), flip(v), lg_b, s_b)

    def finish(o, gate):
        B, L = o.shape[:2]
        o32 = o.astype(jnp.float32)
        mu = jnp.mean(o32, axis=-1, keepdims=True)
        var = jnp.mean(jnp.square(o32 - mu), axis=-1, keepdims=True)
        y = ((o32 - mu) * lax.rsqrt(var + NORM_EPS)).reshape(B, L, H * dv) * gn_g.astype(jnp.float32)
        return (jax.nn.silu(gate) * y.astype(gate.dtype)) @ w_out

    return finish(o_f + flip(o_b), g), finish(oc_f + flip(oc_b), gc)


def _swiglu(h, wg, wu, wd):
    return (jax.nn.silu(h @ wg) * (h @ wu)) @ wd


def setup_inputs(seed: int = 0) -> dict:
    key = jax.random.key(seed)
    ks = jax.random.split(key, 32)
    f32 = jnp.float32

    def nrm(i, shape, scale):
        return jax.random.normal(ks[i], shape, f32) * scale

    decay_base = jnp.log(2.0 ** (5.0 + jnp.arange(RET_HEADS, dtype=f32)) - 1.0)
    return {
        "x": nrm(0, (BATCH, SEQ, D_MODEL), 1.0),
        "c": nrm(1, (BATCH, D_MODEL), 1.0),
        "ctx": nrm(2, (BATCH, CTX_LEN, D_MODEL), 1.0),
        "c_ctx": nrm(3, (D_MODEL,), 1.0),
        "mod_w": nrm(4, (DEPTH, D_MODEL, 6 * D_MODEL), 0.5 * D_MODEL ** -0.5),
        "mod_b": nrm(5, (DEPTH, 6 * D_MODEL), 0.02),
        "norm_mix_g": 1.0 + nrm(6, (DEPTH, D_MODEL), 0.02),
        "norm_ffn_g": 1.0 + nrm(7, (DEPTH, D_MODEL), 0.02),
        "ffn_w_gate": nrm(8, (DEPTH, D_MODEL, FFN_HIDDEN), D_MODEL ** -0.5),
        "ffn_w_up": nrm(9, (DEPTH, D_MODEL, FFN_HIDDEN), D_MODEL ** -0.5),
        "ffn_w_down": nrm(10, (DEPTH, FFN_HIDDEN, D_MODEL), FFN_HIDDEN ** -0.5),
        "ab_w_in": nrm(11, (N_AB, D_MODEL, AB_IN), D_MODEL ** -0.5),
        "ab_w_out": nrm(12, (N_AB, AB_OUT, D_MODEL), AB_OUT ** -0.5),
        "swa_sink": nrm(13, (N_AB, SWA_HEADS), 0.5),
        "mla_q_norm_g": 1.0 + nrm(14, (N_AB, MLA_Q_RANK), 0.02),
        "mla_w_q_b": nrm(15, (N_AB, MLA_Q_RANK, MLA_HEADS * (MLA_NOPE_DIM + MLA_ROPE_DIM)), MLA_Q_RANK ** -0.5),
        "mla_kv_norm_g": 1.0 + nrm(16, (N_AB, MLA_KV_RANK), 0.02),
        "mla_w_kv_b": nrm(17, (N_AB, MLA_KV_RANK, MLA_HEADS * (MLA_NOPE_DIM + MLA_V_DIM)), MLA_KV_RANK ** -0.5),
        "ret_w_in": nrm(18, (N_RET, D_MODEL, RET_IN), D_MODEL ** -0.5),
        "ret_decay_logit_fwd": decay_base + nrm(19, (N_RET, RET_HEADS), 0.1),
        "ret_decay_logit_bwd": decay_base + nrm(20, (N_RET, RET_HEADS), 0.1),
        "ret_gn_g": 1.0 + nrm(21, (N_RET, RET_OUT), 0.02),
        "ret_w_out": nrm(22, (N_RET, RET_OUT, D_MODEL), RET_OUT ** -0.5),
        "final_norm_g": 1.0 + nrm(23, (D_MODEL,), 0.02),
    }


def reference(x, c, ctx, c_ctx, mod_w, mod_b, norm_mix_g, norm_ffn_g, ffn_w_gate, ffn_w_up, ffn_w_down,
              ab_w_in, ab_w_out, swa_sink, mla_q_norm_g, mla_w_q_b, mla_kv_norm_g, mla_w_kv_b,
              ret_w_in, ret_decay_logit_fwd, ret_decay_logit_bwd, ret_gn_g, ret_w_out, final_norm_g):
    n_tok = x.shape[1]
    rows = n_tok // GRID_W
    row = jnp.repeat(jnp.arange(rows, dtype=jnp.float32), GRID_W)
    col = (jnp.arange(n_tok) % GRID_W).astype(jnp.float32)
    cos_a, sin_a = _axial_rope_tables(row, col, SWA_HEAD_DIM, x.dtype)
    cos_b, sin_b = _axial_rope_tables(row, col, MLA_ROPE_DIM, x.dtype)
    cos_r, sin_r = _axial_rope_tables(row, col, RET_QK_DIM, x.dtype)

    xc = ctx
    for l in range(DEPTH):
        last = l == DEPTH - 1
        sh1, sc1, g1, sh2, sc2, g2 = [t[:, None, :] for t in _modulation(c, mod_w[l], mod_b[l])]
        csh1, csc1, cg1, csh2, csc2, cg2 = _modulation(c_ctx, mod_w[l], mod_b[l])
        h = _rmsnorm(x, norm_mix_g[l]) * (1.0 + sc1) + sh1
        hc = _rmsnorm(xc, norm_mix_g[l]) * (1.0 + csc1) + csh1
        i = l // 2
        if l % 2 == 0:
            o, oc = _ab_mixer(h, hc, ab_w_in[i], ab_w_out[i], swa_sink[i], mla_q_norm_g[i], mla_w_q_b[i],
                              mla_kv_norm_g[i], mla_w_kv_b[i], cos_a, sin_a, cos_b, sin_b)
        else:
            o, oc = _retention_mixer(h, hc, ret_w_in[i], ret_decay_logit_fwd[i], ret_decay_logit_bwd[i],
                                     ret_gn_g[i], ret_w_out[i], cos_r, sin_r)
        x = x + g1 * o
        h = _rmsnorm(x, norm_ffn_g[l]) * (1.0 + sc2) + sh2
        x = x + g2 * _swiglu(h, ffn_w_gate[l], ffn_w_up[l], ffn_w_down[l])
        if not last:
            xc = xc + cg1 * oc
            hc = _rmsnorm(xc, norm_ffn_g[l]) * (1.0 + csc2) + csh2
            xc = xc + cg2 * _swiglu(hc, ffn_w_gate[l], ffn_w_up[l], ffn_w_down[l])
    return _rmsnorm(x, final_norm_g)
```

```cpp
#include <hip/hip_runtime.h>
#include <hip/hip_cooperative_groups.h>
#include <cstdio>
namespace cg = cooperative_groups;

typedef unsigned short bf16_t;
typedef short bf16x8 __attribute__((ext_vector_type(8)));
typedef short s16x4 __attribute__((ext_vector_type(4)));
typedef float f32x4 __attribute__((ext_vector_type(4)));
typedef float f32x2 __attribute__((ext_vector_type(2)));
typedef float f32x16 __attribute__((ext_vector_type(16)));
typedef __bf16 bf16v2 __attribute__((ext_vector_type(2)));
typedef unsigned u32x2 __attribute__((ext_vector_type(2)));
typedef unsigned u32x4 __attribute__((ext_vector_type(4)));
#define DI __device__ __forceinline__

constexpr int DM = 2048, NBATCH = 4, SEQ = 4096, CTXL = 256, PB = 4352, NROW = 17408, FF = 5632;
constexpr int NTHR = 512;
constexpr size_t MB = 1u << 20;
constexpr float LOG2E = 1.4426950408889634f;

constexpr size_t O_MOD = 0, O_COSA = 1 * MB, O_SINA = 2 * MB, O_COSB = 3 * MB, O_SINB = 3 * MB + MB / 2, O_COSR = 4 * MB, O_SINR = 6 * MB,
                 O_BAR = 8 * MB, O_XCTX = 9 * MB;
constexpr size_t O_WIN0 = 17 * MB, O_WQB = 27 * MB, O_WKVB = 29 * MB, O_WOUT0 = 30 * MB, O_WGU0 = 38 * MB, O_WDN0 = 82 * MB, O_WIN1 = 104 * MB;
constexpr size_t O_H = 152 * MB;
constexpr size_t O_QA = 220 * MB, O_KA = 254 * MB, O_VAT = 263 * MB, O_QLAT = 272 * MB, O_KVLAT = 289 * MB, O_KR = 298 * MB, O_QM = 301 * MB,
                 O_KN = 352 * MB, O_VMT = 386 * MB, O_OCAT = 420 * MB, O_HID0 = 220 * MB;
constexpr size_t O_K1 = 17 * MB, O_Q1 = 220 * MB, O_V1T = 284 * MB, O_G1 = 420 * MB, O_OF = 548 * MB, O_OB = 88 * MB;
constexpr size_t O_WGU1 = 17 * MB, O_WDN1 = 61 * MB, O_WOUT1 = 220 * MB, O_H1 = 284 * MB, O_HID1 = 352 * MB;
constexpr size_t O_PART = 488 * MB;
constexpr size_t WS_NEED = 676 * MB;

struct P {
    const float *x, *c, *ctx, *c_ctx, *mod_w, *mod_b, *norm_mix_g, *norm_ffn_g, *w_gate, *w_up, *w_down, *ab_w_in, *ab_w_out, *sink, *q_norm_g,
        *w_q_b, *kv_norm_g, *w_kv_b, *ret_w_in, *lf, *lb, *gn_g, *ret_w_out, *final_g;
    float* out;
    char* ws;
};

DI unsigned pk2(float lo, float hi) {
    f32x2 v = {lo, hi};
    bf16v2 r = __builtin_convertvector(v, bf16v2);
    return __builtin_bit_cast(unsigned, r);
}
DI float bf2f(unsigned short b) { return __uint_as_float(((unsigned)b) << 16); }
DI bf16x8 pack8(float a0, float a1, float a2, float a3, float a4, float a5, float a6, float a7) {
    u32x4 p = {pk2(a0, a1), pk2(a2, a3), pk2(a4, a5), pk2(a6, a7)};
    return __builtin_bit_cast(bf16x8, p);
}
DI void st4(bf16_t* dst, float a, float b, float c, float d) {
    u32x2 v = {pk2(a, b), pk2(c, d)};
    *(u32x2*)dst = v;
}
DI float wsum(float v) {
#pragma unroll
    for (int o = 32; o > 0; o >>= 1) v += __shfl_xor(v, o);
    return v;
}
DI int tidx() { int t = threadIdx.x; asm volatile("" : "+v"(t)); return t; }
DI float silu_f(float g) { return g * __builtin_amdgcn_rcpf(1.f + __builtin_amdgcn_exp2f(-LOG2E * g)); }
DI int crow(int r, int h) { return (r & 3) + 8 * (r >> 2) + 4 * h; }
#define MFMA32(a, b, c) __builtin_amdgcn_mfma_f32_32x32x16_bf16((a), (b), (c), 0, 0, 0)

DI float* xrow(const P& p, int r) {
    const int b = r / PB, q = r - b * PB;
    return q < CTXL ? (float*)(p.ws + O_XCTX) + (size_t)(b * CTXL + q) * DM : p.out + (size_t)(b * SEQ + q - CTXL) * DM;
}
DI const float* inrow(const P& p, int r) {
    const int b = r / PB, q = r - b * PB;
    return q < CTXL ? p.ctx + (size_t)(b * CTXL + q) * DM : p.x + (size_t)(b * SEQ + q - CTXL) * DM;
}
DI const float* modv(const P& p, int l, int r, int ch) {
    const int b = r / PB, q = r - b * PB;
    const int bb = q < CTXL ? 4 : b;
    return (const float*)(p.ws + O_MOD) + ((size_t)(l * 5 + bb) * 6 + ch) * DM;
}

constexpr int BM = 256, BK = 64, HALF = 128, HT = HALF * BK;
typedef f32x4 Acc[2][2][4][2];
DI int lds_byte(int r, int c) {
    int st = (r >> 4) * 2 + (c >> 5), rr = r & 15, cc = c & 31, ob = rr * 64 + cc * 2;
    return st * 1024 + (ob ^ (((ob >> 9) & 1) << 5));
}
DI void stage_rc(int b, int& R, int& C) {
    int st = b / 1024, sb = b % 1024, swz = sb ^ (((sb >> 9) & 1) << 5);
    R = (st >> 1) * 16 + swz / 64;
    C = (st & 1) * 32 + (swz % 64) / 2;
}
#define LAS __attribute__((address_space(3)))
constexpr int HTB = HALF * BK * 2;
DI void gemm_tile(const bf16_t* __restrict__ A, const bf16_t* __restrict__ Bt, const int K, const int brow, const int bcol, LAS unsigned char* lds, Acc& acc) {
    const int tid = tidx(), wid = __builtin_amdgcn_readfirstlane(tid >> 6), lane = tid & 63, wr = wid >> 2, wc = wid & 3, fr = lane & 15, fq = lane >> 4;
    const int nt = K / BK;
    unsigned voff[2];
#pragma unroll
    for (int i = 0; i < 2; ++i) { int R, C; stage_rc(tid * 16 + i * 8192, R, C); voff[i] = (unsigned)(R * K + C) * 2u; }
    const size_t kstep = (size_t)(BK * 2), hstep = (size_t)HALF * K * 2;
    const unsigned ldsw = (unsigned)wid * 1024u;
    const int aoff = lds_byte(wr * 64 + fr, fq * 8), boff = lds_byte(wc * 32 + fr, fq * 8);
    const char* cA = (const char*)A + (size_t)brow * K * 2;
    const char* cB = (const char*)Bt + (size_t)bcol * K * 2;
#define SAo(b, h) (((b) * 2 + (h)) * HTB)
#define SBo(b, h) ((4 + (b) * 2 + (h)) * HTB)
#define STAGE(bufoff, gbase)                                                                                                       \
    do {                                                                                                                           \
        _Pragma("unroll") for (int _i = 0; _i < 2; ++_i)                                                                           \
            __builtin_amdgcn_global_load_lds((const unsigned*)((const char*)(gbase) + voff[_i]), (LAS unsigned*)(lds + (bufoff) + ldsw + _i * 8192), 16, 0, 0); \
    } while (0)
#define LDA(dst, b, h)                                                                                                             \
    do {                                                                                                                           \
        _Pragma("unroll") for (int m = 0; m < 4; ++m) _Pragma("unroll") for (int k = 0; k < 2; ++k)                                \
            dst[m][k] = *(const LAS bf16x8*)(lds + SAo(b, h) + aoff + m * 2048 + k * 1024);                                        \
    } while (0)
#define LDB(dst, b, h)                                                                                                             \
    do {                                                                                                                           \
        _Pragma("unroll") for (int n = 0; n < 2; ++n) _Pragma("unroll") for (int k = 0; k < 2; ++k)                                \
            dst[n][k] = *(const LAS bf16x8*)(lds + SBo(b, h) + boff + n * 2048 + k * 1024);                                        \
    } while (0)
#define MMA(ai, bj, At, Bx)                                                                                                        \
    do {                                                                                                                           \
        __builtin_amdgcn_s_setprio(1);                                                                                             \
        _Pragma("unroll") for (int m = 0; m < 4; ++m) _Pragma("unroll") for (int n = 0; n < 2; ++n) _Pragma("unroll") for (int k = 0; k < 2; ++k) \
            acc[ai][bj][m][n] = __builtin_amdgcn_mfma_f32_16x16x32_bf16(Bx[n][k], At[m][k], acc[ai][bj][m][n], 0, 0, 0);           \
        __builtin_amdgcn_s_setprio(0);                                                                                             \
    } while (0)
#define WAIT_V(n) asm volatile("s_waitcnt vmcnt(" #n ")" ::: "memory")
#define WAIT_L(n) asm volatile("s_waitcnt lgkmcnt(" #n ")" ::: "memory")
#define BAR __builtin_amdgcn_s_barrier()
#define SCHED __builtin_amdgcn_sched_barrier(0)
#pragma unroll
    for (int a = 0; a < 2; ++a)
#pragma unroll
        for (int b = 0; b < 2; ++b)
#pragma unroll
            for (int m = 0; m < 4; ++m)
#pragma unroll
                for (int n = 0; n < 2; ++n) acc[a][b][m][n] = (f32x4){0.f, 0.f, 0.f, 0.f};
    bf16x8 At[4][2], B0[2][2], B1[2][2];
    STAGE(SBo(0, 0), cB); STAGE(SAo(0, 0), cA); STAGE(SBo(0, 1), cB + hstep); STAGE(SAo(0, 1), cA + hstep);
    if (wr == 1) BAR;
    WAIT_V(4); BAR;
    STAGE(SBo(1, 0), cB + kstep); STAGE(SAo(1, 0), cA + kstep); STAGE(SBo(1, 1), cB + hstep + kstep);
    WAIT_V(6); BAR;
    for (int t = 0; t < nt - 2; t += 2) {
        const char* a1 = cA + (size_t)(t + 1) * kstep;
        const char* a2 = cA + (size_t)(t + 2) * kstep; const char* b2 = cB + (size_t)(t + 2) * kstep;
        const char* a3 = a2 + kstep; const char* b3 = b2 + kstep;
        LDB(B0, 0, 0); SCHED; LDA(At, 0, 0); STAGE(SAo(1, 1), a1 + hstep);
        WAIT_L(8); BAR; WAIT_L(0); MMA(0, 0, At, B0); BAR; SCHED;
        LDB(B1, 0, 1); STAGE(SBo(0, 0), b2);
        BAR; WAIT_L(0); MMA(0, 1, At, B1); BAR;
        LDA(At, 0, 1); STAGE(SAo(0, 0), a2);
        BAR; WAIT_L(0); MMA(1, 0, At, B0); BAR; SCHED;
        STAGE(SBo(0, 1), b2 + hstep);
        WAIT_V(6); BAR; MMA(1, 1, At, B1); BAR;
        LDB(B0, 1, 0); SCHED; LDA(At, 1, 0); STAGE(SAo(0, 1), a2 + hstep);
        WAIT_L(8); BAR; WAIT_L(0); MMA(0, 0, At, B0); BAR; SCHED;
        LDB(B1, 1, 1); STAGE(SBo(1, 0), b3);
        BAR; WAIT_L(0); MMA(0, 1, At, B1); BAR;
        LDA(At, 1, 1); STAGE(SAo(1, 0), a3);
        BAR; WAIT_L(0); MMA(1, 0, At, B0); BAR; SCHED;
        STAGE(SBo(1, 1), b3 + hstep);
        WAIT_V(6); BAR; MMA(1, 1, At, B1); BAR;
    }
    { LDB(B0, 0, 0); LDA(At, 0, 0); STAGE(SAo(1, 1), cA + (size_t)(nt - 1) * kstep + hstep);
      BAR; WAIT_L(0); MMA(0, 0, At, B0); BAR;
      LDB(B1, 0, 1); BAR; WAIT_L(0); MMA(0, 1, At, B1); BAR;
      LDA(At, 0, 1); WAIT_V(4); BAR; WAIT_L(0); MMA(1, 0, At, B0); MMA(1, 1, At, B1); BAR; }
    { LDB(B0, 1, 0); LDA(At, 1, 0); WAIT_V(2); BAR; WAIT_L(0); MMA(0, 0, At, B0); BAR;
      LDB(B1, 1, 1); WAIT_V(0); BAR; WAIT_L(0); MMA(0, 1, At, B1); BAR;
      LDA(At, 1, 1); BAR; WAIT_L(0); MMA(1, 0, At, B0); MMA(1, 1, At, B1); BAR; }
    if (wr == 0) BAR;
#undef SAo
#undef SBo
#undef STAGE
#undef LDA
#undef LDB
#undef MMA
}
struct Unit { const char* A; const char* B; int pm, pn; };
template <class Get, class Epi>
DI void gemm_stream(LAS unsigned char* lds, const int K, const int ld, Get get, Epi epi) {
    const int tid = tidx(), wid = __builtin_amdgcn_readfirstlane(tid >> 6), lane = tid & 63, wr = wid >> 2, wc = wid & 3, fr = lane & 15, fq = lane >> 4;
    const int nt = K / BK;
    unsigned voff[2];
#pragma unroll
    for (int i = 0; i < 2; ++i) { int R, C; stage_rc(tid * 16 + i * 8192, R, C); voff[i] = (unsigned)(R * ld + C) * 2u; }
    const size_t kstep = (size_t)(BK * 2), hstep = (size_t)HALF * ld * 2;
    const unsigned ldsw = (unsigned)wid * 1024u;
    const int aoff = lds_byte(wr * 64 + fr, fq * 8), boff = lds_byte(wc * 32 + fr, fq * 8);
#define SAo(b, h) (((b) * 2 + (h)) * HTB)
#define SBo(b, h) ((4 + (b) * 2 + (h)) * HTB)
#define STAGE(bufoff, gbase)                                                                                                       \
    do {                                                                                                                           \
        _Pragma("unroll") for (int _i = 0; _i < 2; ++_i)                                                                           \
            __builtin_amdgcn_global_load_lds((const unsigned*)((const char*)(gbase) + voff[_i]), (LAS unsigned*)(lds + (bufoff) + ldsw + _i * 8192), 16, 0, 0); \
    } while (0)
#define LDA(dst, b, h)                                                                                                             \
    do {                                                                                                                           \
        _Pragma("unroll") for (int m = 0; m < 4; ++m) _Pragma("unroll") for (int k = 0; k < 2; ++k)                                \
            dst[m][k] = *(const LAS bf16x8*)(lds + SAo(b, h) + aoff + m * 2048 + k * 1024);                                        \
    } while (0)
#define LDB(dst, b, h)                                                                                                             \
    do {                                                                                                                           \
        _Pragma("unroll") for (int n = 0; n < 2; ++n) _Pragma("unroll") for (int k = 0; k < 2; ++k)                                \
            dst[n][k] = *(const LAS bf16x8*)(lds + SBo(b, h) + boff + n * 2048 + k * 1024);                                        \
    } while (0)
#define MMA(ai, bj, At, Bx)                                                                                                        \
    do {                                                                                                                           \
        __builtin_amdgcn_s_setprio(1);                                                                                             \
        _Pragma("unroll") for (int m = 0; m < 4; ++m) _Pragma("unroll") for (int n = 0; n < 2; ++n) _Pragma("unroll") for (int k = 0; k < 2; ++k) \
            acc[ai][bj][m][n] = __builtin_amdgcn_mfma_f32_16x16x32_bf16(Bx[n][k], At[m][k], acc[ai][bj][m][n], 0, 0, 0);           \
        __builtin_amdgcn_s_setprio(0);                                                                                             \
    } while (0)
#define ZERO_ACC                                                                                                                   \
    _Pragma("unroll") for (int a = 0; a < 2; ++a) _Pragma("unroll") for (int b = 0; b < 2; ++b) _Pragma("unroll") for (int m = 0; m < 4; ++m) \
        _Pragma("unroll") for (int n = 0; n < 2; ++n) acc[a][b][m][n] = (f32x4){0.f, 0.f, 0.f, 0.f}
    Unit cur, nxt;
    int ui = 0;
    if (!get(0, cur)) return;
    Acc acc;
    ZERO_ACC;
    bf16x8 At[4][2], B0[2][2], B1[2][2];
    const char* cA = cur.A;
    const char* cB = cur.B;
    STAGE(SBo(0, 0), cB); STAGE(SAo(0, 0), cA); STAGE(SBo(0, 1), cB + hstep); STAGE(SAo(0, 1), cA + hstep);
    if (wr == 1) BAR;
    WAIT_V(4); BAR;
    STAGE(SBo(1, 0), cB + kstep); STAGE(SAo(1, 0), cA + kstep); STAGE(SBo(1, 1), cB + hstep + kstep);
    WAIT_V(6); BAR;
    for (;;) {
        const bool has_next = get(ui + 1, nxt);
        const char* nA = has_next ? nxt.A : cA;
        const char* nB = has_next ? nxt.B : cB;
        for (int t = 0; t < nt; t += 2) {
            const bool last = (t == nt - 2);
            const char* a1 = cA + (size_t)(t + 1) * kstep;
            const char* a2 = last ? nA : cA + (size_t)(t + 2) * kstep;
            const char* b2 = last ? nB : cB + (size_t)(t + 2) * kstep;
            const char* a3 = a2 + kstep;
            const char* b3 = b2 + kstep;
            LDB(B0, 0, 0); SCHED; LDA(At, 0, 0); STAGE(SAo(1, 1), a1 + hstep);
            WAIT_L(8); BAR; WAIT_L(0); MMA(0, 0, At, B0); BAR; SCHED;
            LDB(B1, 0, 1); STAGE(SBo(0, 0), b2);
            BAR; WAIT_L(0); MMA(0, 1, At, B1); BAR;
            LDA(At, 0, 1); STAGE(SAo(0, 0), a2);
            BAR; WAIT_L(0); MMA(1, 0, At, B0); BAR; SCHED;
            STAGE(SBo(0, 1), b2 + hstep);
            WAIT_V(6); BAR; MMA(1, 1, At, B1); BAR;
            LDB(B0, 1, 0); SCHED; LDA(At, 1, 0); STAGE(SAo(0, 1), a2 + hstep);
            WAIT_L(8); BAR; WAIT_L(0); MMA(0, 0, At, B0); BAR; SCHED;
            LDB(B1, 1, 1); STAGE(SBo(1, 0), b3);
            BAR; WAIT_L(0); MMA(0, 1, At, B1); BAR;
            LDA(At, 1, 1); STAGE(SAo(1, 0), a3);
            BAR; WAIT_L(0); MMA(1, 0, At, B0); BAR; SCHED;
            STAGE(SBo(1, 1), b3 + hstep);
            WAIT_V(6); BAR; MMA(1, 1, At, B1); BAR;
        }
        epi(acc, cur);
        if (!has_next) break;
        ZERO_ACC;
        cur = nxt; cA = nA; cB = nB; ++ui;
    }
    WAIT_V(0);
    if (wr == 0) BAR;
    BAR;
#undef SAo
#undef SBo
#undef STAGE
#undef LDA
#undef LDB
#undef MMA
#undef ZERO_ACC
}
#define EPI_IDX int tidx_ = threadIdx.x; asm volatile("" : "+v"(tidx_)); const int wid = tidx_ >> 6, lane = tidx_ & 63, wr = wid >> 2, wc = wid & 3, fr = lane & 15, fq = lane >> 4; (void)wc; (void)fq; (void)fr; (void)wr;
#define EPI_DONE do { } while (0)

DI void tile_of(int L, int nM, int nN, int& pm, int& pn) {
    const int nwg = nM * nN;
    int wgid = L;
    { const int q = nwg / 8, r = nwg % 8, xcd = wgid % 8, off = wgid / 8; wgid = (xcd < r ? xcd * (q + 1) : r * (q + 1) + (xcd - r) * q) + off; }
    constexpr int WGM = 4;
    const int nig = WGM * nN, gid = wgid / nig, fm = gid * WGM, gsz = (nM - fm) < WGM ? (nM - fm) : WGM;
    pm = fm + ((wgid % nig) % gsz);
    pn = (wgid % nig) / gsz;
}

DI void epi_plain(const Acc& acc, int brow, bf16_t* dst, int ld, int coff, const float* rs) {
    EPI_IDX
#pragma unroll
    for (int ai = 0; ai < 2; ++ai)
#pragma unroll
        for (int m = 0; m < 4; ++m) {
            const int lr = ai * 128 + wr * 64 + m * 16 + fr;
            const float s = rs ? rs[lr] : 1.f;
            bf16_t* rp = dst + (size_t)(brow + lr) * ld + coff + wc * 32 + fq * 4;
#pragma unroll
            for (int bj = 0; bj < 2; ++bj)
#pragma unroll
                for (int n = 0; n < 2; ++n) { const f32x4 v = acc[ai][bj][m][n]; st4(rp + bj * 128 + n * 16, v[0] * s, v[1] * s, v[2] * s, v[3] * s); }
        }
    EPI_DONE;
}
template <int R>
DI void epi_rope(const Acc& acc, const P& p, int brow, bf16_t* __restrict__ dst, int ld, int coff, int bstride, const float* rs, int nblk_valid) {
    EPI_IDX
    const float* __restrict__ cosT = (const float*)(p.ws + (R == 128 ? O_COSA : O_COSB));
    const float* __restrict__ sinT = (const float*)(p.ws + (R == 128 ? O_SINA : O_SINB));
    const int b = brow / PB, p0 = brow - b * PB;
    const bool ctx = p0 < CTXL;
#pragma unroll
    for (int ai = 0; ai < 2; ++ai)
#pragma unroll
        for (int m = 0; m < 4; ++m) {
            const int lr = ai * 128 + wr * 64 + m * 16 + fr;
            const float s = rs ? rs[lr] : 1.f;
            const int sq = p0 + lr - CTXL;
#pragma unroll
            for (int bj = 0; bj < 2; ++bj) {
                const int blk = R == 128 ? bj : bj * 2 + (wc >> 1);
                const int d0 = (R == 128 ? wc * 16 : (wc & 1) * 16) + fq * 4;
                if (blk < nblk_valid) {
                    f32x4 cv = {1.f, 1.f, 1.f, 1.f}, sv = {0.f, 0.f, 0.f, 0.f};
                    if (!ctx) { cv = *(const f32x4*)(cosT + (size_t)sq * (R / 2) + d0); sv = *(const f32x4*)(sinT + (size_t)sq * (R / 2) + d0); }
                    const f32x4 x1 = acc[ai][bj][m][0] * s, x2 = acc[ai][bj][m][1] * s;
                    const f32x4 o1 = x1 * cv - x2 * sv, o2 = x1 * sv + x2 * cv;
                    bf16_t* rp = dst + (size_t)(brow + lr) * ld + coff + blk * bstride + d0;
                    st4(rp, o1[0], o1[1], o1[2], o1[3]);
                    st4(rp + R / 2, o2[0], o2[1], o2[2], o2[3]);
                }
                __builtin_amdgcn_sched_barrier(0);
            }
        }
    EPI_DONE;
}
DI void epi_rope256(const Acc& acc, const P& p, int brow, bf16_t* __restrict__ dst, size_t dstrow0, int coff, float scale) {
    EPI_IDX
    const float* __restrict__ cosT = (const float*)(p.ws + O_COSR);
    const float* __restrict__ sinT = (const float*)(p.ws + O_SINR);
    const int b = brow / PB, p0 = brow - b * PB;
    const bool ctx = p0 < CTXL;
#pragma unroll
    for (int ai = 0; ai < 2; ++ai)
#pragma unroll
        for (int m = 0; m < 4; ++m) {
            const int lr = ai * 128 + wr * 64 + m * 16 + fr;
            const int sq = p0 + lr - CTXL;
#pragma unroll
            for (int n = 0; n < 2; ++n) {
                const int d0 = wc * 32 + n * 16 + fq * 4;
                f32x4 cv = {1.f, 1.f, 1.f, 1.f}, sv = {0.f, 0.f, 0.f, 0.f};
                if (!ctx) { cv = *(const f32x4*)(cosT + (size_t)sq * 128 + d0); sv = *(const f32x4*)(sinT + (size_t)sq * 128 + d0); }
                const f32x4 x1 = acc[ai][0][m][n] * scale, x2 = acc[ai][1][m][n] * scale;
                const f32x4 o1 = x1 * cv - x2 * sv, o2 = x1 * sv + x2 * cv;
                bf16_t* rp = dst + (dstrow0 + lr) * (size_t)DM + coff + d0;
                st4(rp, o1[0], o1[1], o1[2], o1[3]);
                st4(rp + 128, o2[0], o2[1], o2[2], o2[3]);
            }
        }
    EPI_DONE;
}
template <int CH>
DI void epi_T(const Acc& acc, int f0, int tok0, bf16_t* dst, int NF, const float* rs) {
    EPI_IDX
    const int b = tok0 / PB, p0 = tok0 - b * PB;
#pragma unroll
    for (int ai = 0; ai < 2; ++ai)
#pragma unroll
        for (int m = 0; m < 4; ++m) {
            const int feat = f0 + ai * 128 + wr * 64 + m * 16 + fr;
#pragma unroll
            for (int bj = 0; bj < 2; ++bj)
#pragma unroll
                for (int n = 0; n < 2; ++n) {
                    const int lc = bj * 128 + wc * 32 + n * 16 + fq * 4;
                    f32x4 v = acc[ai][bj][m][n];
                    if (rs) { v[0] *= rs[lc]; v[1] *= rs[lc + 1]; v[2] *= rs[lc + 2]; v[3] *= rs[lc + 3]; }
                    const int pp = p0 + lc;
                    st4(dst + (((size_t)b * (PB / CH) + pp / CH) * NF + feat) * CH + pp % CH, v[0], v[1], v[2], v[3]);
                }
        }
    EPI_DONE;
}
DI void epi_resid(const Acc& acc, const P& p, int brow, int bcol, int layer, int gch, bool from_input) {
    EPI_IDX
    const float* gate = modv(p, layer, brow, gch);
#pragma unroll
    for (int bj = 0; bj < 2; ++bj)
#pragma unroll
        for (int n = 0; n < 2; ++n) {
            const int c0 = bcol + bj * 128 + wc * 32 + n * 16 + fq * 4;
            const f32x4 g = *(const f32x4*)(gate + c0);
            f32x4 xv[2][4];
#pragma unroll
            for (int ai = 0; ai < 2; ++ai)
#pragma unroll
                for (int m = 0; m < 4; ++m) {
                    const int r = brow + ai * 128 + wr * 64 + m * 16 + fr;
                    const float* sp = (from_input ? inrow(p, r) : xrow(p, r)) + c0;
                    xv[ai][m] = *(const f32x4*)sp;
                }
            __builtin_amdgcn_sched_barrier(0);
#pragma unroll
            for (int ai = 0; ai < 2; ++ai)
#pragma unroll
                for (int m = 0; m < 4; ++m) {
                    const int r = brow + ai * 128 + wr * 64 + m * 16 + fr;
                    *(f32x4*)(xrow(p, r) + c0) = xv[ai][m] + g * acc[ai][bj][m][n];
                }
            __builtin_amdgcn_sched_barrier(0);
        }
    EPI_DONE;
}
DI void epi_part(const Acc& acc, const P& p, int brow, int bcol, int sl) {
    EPI_IDX
    const int b = brow / PB;
    float* part = (float*)(p.ws + O_PART) + ((size_t)sl * (NBATCH * CTXL) + b * CTXL) * DM;
#pragma unroll
    for (int ai = 0; ai < 2; ++ai)
#pragma unroll
        for (int m = 0; m < 4; ++m) {
            float* rp = part + (size_t)(ai * 128 + wr * 64 + m * 16 + fr) * DM + bcol + wc * 32 + fq * 4;
#pragma unroll
            for (int bj = 0; bj < 2; ++bj)
#pragma unroll
                for (int n = 0; n < 2; ++n) *(f32x4*)(rp + bj * 128 + n * 16) = acc[ai][bj][m][n];
        }
    EPI_DONE;
}
DI void epi_swiglu(const Acc& acc, int brow, int pn, bf16_t* hid) {
    EPI_IDX
#pragma unroll
    for (int ai = 0; ai < 2; ++ai)
#pragma unroll
        for (int m = 0; m < 4; ++m) {
            const int r = brow + ai * 128 + wr * 64 + m * 16 + fr;
            bf16_t* rp = hid + (size_t)r * FF + pn * 128 + wc * 32 + fq * 4;
#pragma unroll
            for (int n = 0; n < 2; ++n) {
                const f32x4 g = acc[ai][0][m][n], u = acc[ai][1][m][n];
                float o[4];
#pragma unroll
                for (int j = 0; j < 4; ++j) o[j] = silu_f(g[j]) * u[j];
                st4(rp + n * 16, o[0], o[1], o[2], o[3]);
            }
        }
    EPI_DONE;
}

DI int perm128(int q) { return 64 * ((q >> 4) & 1) + 16 * (q >> 5) + (q & 15); }
DI int perm64(int q) { return 32 * ((q >> 4) & 1) + 16 * (q >> 5) + (q & 15); }
enum { CK_NAT = 0, CK_IN0, CK_QB, CK_KVB, CK_GU };
DI int srccol(int kind, int pos, int& which) {
    which = 0;
    switch (kind) {
        case CK_IN0: {
            if (pos < 1280) { const int blk = pos >> 7; return blk * 128 + perm128(pos & 127); }
            if (pos < 2304) return pos;
            const int q = pos - 2304;
            return q < 64 ? 2304 + perm64(q) : -1;
        }
        case CK_QB: {
            if (pos < 1024) return (pos >> 7) * 192 + (pos & 127);
            const int qq = pos - 1024;
            return (qq >> 6) * 192 + 128 + perm64(qq & 63);
        }
        case CK_KVB: {
            if (pos < 1024) return (pos >> 7) * 256 + (pos & 127);
            const int qq = pos - 1024;
            return (qq >> 7) * 256 + 128 + (qq & 127);
        }
        case CK_GU: {
            const int t = pos >> 8, q = pos & 255;
            which = q >> 7;
            return t * 128 + (q & 127);
        }
        default: return pos;
    }
}
DI void conv_tile(const float* s1, const float* s2, const float* kscale, bf16_t* dst, int K, int Nsrc, int Ndst, int kind, int tile, float* lt  ) {
    const int tid = tidx();
    const int nnt = Ndst / 256;
    const int n0 = (tile % nnt) * 256, k0 = (tile / nnt) * 64;
    {
        const int nn = tid & 255, kk0 = tid >> 8;
        int which;
        const int sc = srccol(kind, n0 + nn, which);
        const float* s = (which ? s2 : s1) + (size_t)k0 * Nsrc + (sc >= 0 ? sc : 0);
        float v[32], ksv[32];
#pragma unroll
        for (int i = 0; i < 32; ++i) v[i] = sc >= 0 ? s[(size_t)(kk0 + 2 * i) * Nsrc] : 0.f;
#pragma unroll
        for (int i = 0; i < 32; ++i) ksv[i] = kscale ? kscale[k0 + kk0 + 2 * i] : 1.f;
#pragma unroll
        for (int i = 0; i < 32; ++i) {
            const int kk = kk0 + 2 * i;
            lt[kk * 257 + nn] = v[i] * ksv[i];
        }
    }
    __syncthreads();
#pragma unroll
    for (int i = 0; i < 4; ++i) {
        const int c = tid + NTHR * i, n = c >> 3, kc = c & 7;
        float v[8];
#pragma unroll
        for (int e = 0; e < 8; ++e) v[e] = lt[(kc * 8 + e) * 257 + n];
        *(bf16x8*)(dst + (size_t)(n0 + n) * K + k0 + kc * 8) = pack8(v[0], v[1], v[2], v[3], v[4], v[5], v[6], v[7]);
    }
    __syncthreads();
}
DI void conv_job(const float* s1, const float* s2, const float* ks, bf16_t* dst, int K, int Nsrc, int Ndst, int kind, int& base, char* shm) {
    const int nt = (Ndst / 256) * (K / 64);
    const int first = ((int)blockIdx.x - (base % (int)gridDim.x) + (int)gridDim.x) % (int)gridDim.x;
    for (int t = first; t < nt; t += gridDim.x) conv_tile(s1, s2, ks, dst, K, Nsrc, Ndst, kind, t, (float*)shm);
    base += nt;
}

DI void phase0(const P& p, char* shm) {
    const int tid = tidx();
    {
        float* sc = (float*)shm;
        float* part = (float*)(shm + 5 * DM * 4);
        for (int i = tid; i < 5 * DM; i += NTHR) {
            const int r = i / DM, k = i - r * DM;
            const float v = r < 4 ? p.c[r * DM + k] : p.c_ctx[k];
            sc[i] = v / (1.f + __expf(-v));
        }
        __syncthreads();
        for (int item = blockIdx.x; item < 384; item += gridDim.x) {
            const int cl = tid & 63, ks = tid >> 6;
            const int gc = item * 64 + cl, layer = gc / 12288, col = gc - layer * 12288;
            const float* w = p.mod_w + ((size_t)layer * DM + ks * 256) * 12288 + col;
            float a0 = 0.f, a1 = 0.f, a2 = 0.f, a3 = 0.f, a4 = 0.f;
#pragma unroll 16
            for (int k = 0; k < 256; ++k) {
                const float wv = w[(size_t)k * 12288];
                const int kk = ks * 256 + k;
                a0 += sc[kk] * wv; a1 += sc[DM + kk] * wv; a2 += sc[2 * DM + kk] * wv; a3 += sc[3 * DM + kk] * wv; a4 += sc[4 * DM + kk] * wv;
            }
            float* q = part + (ks * 64 + cl) * 5;
            q[0] = a0; q[1] = a1; q[2] = a2; q[3] = a3; q[4] = a4;
            __syncthreads();
            if (tid < 320) {
                const int c2 = tid & 63, r = tid >> 6;
                const int gc2 = item * 64 + c2, layer2 = gc2 / 12288, col2 = gc2 - layer2 * 12288;
                float sum = p.mod_b[layer2 * 12288 + col2];
#pragma unroll
                for (int k8 = 0; k8 < 8; ++k8) sum += part[(k8 * 64 + c2) * 5 + r];
                ((float*)(p.ws + O_MOD))[((size_t)layer2 * 5 + r) * 12288 + col2] = sum;
            }
            __syncthreads();
        }
        __syncthreads();
    }
    {
        const int total = SEQ * 224;
        for (int i = blockIdx.x * NTHR + tid; i < total; i += gridDim.x * NTHR) {
            const int s = i / 224, e = i - s * 224;
            int nf, d; float *ct, *st;
            if (e < 64) { nf = 32; d = e; ct = (float*)(p.ws + O_COSA) + s * 64 + d; st = (float*)(p.ws + O_SINA) + s * 64 + d; }
            else if (e < 96) { nf = 16; d = e - 64; ct = (float*)(p.ws + O_COSB) + s * 32 + d; st = (float*)(p.ws + O_SINB) + s * 32 + d; }
            else { nf = 64; d = e - 96; ct = (float*)(p.ws + O_COSR) + s * 128 + d; st = (float*)(p.ws + O_SINR) + s * 128 + d; }
            const int fi = d < nf ? d : d - nf;
            const float pos = d < nf ? (float)(s >> 6) : (float)(s & 63);
            const float inv = exp2f(-(float)fi / (float)nf * 13.287712379549449f);
            const float ang = pos * inv;
            float rev = ang * 0.15915494309189535f;
            rev -= rintf(rev);
            *ct = __builtin_amdgcn_cosf(rev);
            *st = __builtin_amdgcn_sinf(rev);
        }
    }
    {
        int base = 0;
        conv_job(p.ab_w_in, nullptr, nullptr, (bf16_t*)(p.ws + O_WIN0), DM, 2368, 2560, CK_IN0, base, shm);
        conv_job(p.w_q_b, nullptr, p.q_norm_g, (bf16_t*)(p.ws + O_WQB), 512, 1536, 1536, CK_QB, base, shm);
        conv_job(p.w_kv_b, nullptr, p.kv_norm_g, (bf16_t*)(p.ws + O_WKVB), 256, 2048, 2048, CK_KVB, base, shm);
        conv_job(p.ab_w_out, nullptr, nullptr, (bf16_t*)(p.ws + O_WOUT0), DM, DM, DM, CK_NAT, base, shm);
        conv_job(p.w_gate, p.w_up, nullptr, (bf16_t*)(p.ws + O_WGU0), DM, FF, 2 * FF, CK_GU, base, shm);
        conv_job(p.w_down, nullptr, nullptr, (bf16_t*)(p.ws + O_WDN0), FF, DM, DM, CK_NAT, base, shm);
        conv_job(p.ret_w_in, nullptr, nullptr, (bf16_t*)(p.ws + O_WIN1), DM, 12288, 12288, CK_NAT, base, shm);
    }
}

DI void phase_norm(const P& p, int layer, int which, bool from_input, bf16_t* H, bool skip_ctx, int pendS, int pend_layer, int pend_gch) {
    const int tix = tidx(), lane = tix & 63, gw = blockIdx.x * (NTHR / 64) + (tix >> 6), nw = gridDim.x * (NTHR / 64);
    const float* g = (which ? p.norm_ffn_g : p.norm_mix_g) + layer * DM;
    for (int r = gw; r < NROW; r += nw) {
        const int b = r / PB, q = r - b * PB;
        if (skip_ctx && q < CTXL) continue;
        const float* src = from_input ? inrow(p, r) : xrow(p, r);
        f32x4 v[8];
        float ss = 0.f;
#pragma unroll
        for (int i = 0; i < 8; ++i) { v[i] = *(const f32x4*)(src + (i * 64 + lane) * 4); ss += v[i][0] * v[i][0] + v[i][1] * v[i][1] + v[i][2] * v[i][2] + v[i][3] * v[i][3]; }
        if (pendS > 0 && q < CTXL) {
            const float* part = (const float*)(p.ws + O_PART) + (size_t)(b * CTXL + q) * DM;
            const float* gate = modv(p, pend_layer, r, pend_gch);
            float* xr = xrow(p, r);
            ss = 0.f;
#pragma unroll
            for (int i = 0; i < 8; ++i) {
                const int c = (i * 64 + lane) * 4;
                f32x4 a = {0.f, 0.f, 0.f, 0.f};
                for (int s = 0; s < pendS; ++s) a += *(const f32x4*)(part + (size_t)s * (NBATCH * CTXL) * DM + c);
                v[i] += *(const f32x4*)(gate + c) * a;
                *(f32x4*)(xr + c) = v[i];
                ss += v[i][0] * v[i][0] + v[i][1] * v[i][1] + v[i][2] * v[i][2] + v[i][3] * v[i][3];
            }
        }
        ss = wsum(ss);
        if (from_input && q < CTXL) {
            float* xr = xrow(p, r);
#pragma unroll
            for (int i = 0; i < 8; ++i) *(f32x4*)(xr + (i * 64 + lane) * 4) = v[i];
        }
        const float rinv = rsqrtf(ss * (1.f / DM) + 1e-6f);
        const float* sh = modv(p, layer, r, which ? 3 : 0);
        const float* sc = modv(p, layer, r, which ? 4 : 1);
#pragma unroll
        for (int i = 0; i < 8; ++i) {
            const int c = (i * 64 + lane) * 4;
            const f32x4 gv = *(const f32x4*)(g + c), sv = *(const f32x4*)(sc + c), hv = *(const f32x4*)(sh + c);
            const f32x4 o = v[i] * rinv * gv * (1.f + sv) + hv;
            st4(H + (size_t)r * DM + c, o[0], o[1], o[2], o[3]);
        }
    }
}
DI void phase_final(const P& p) {
    const int tix = tidx(), lane = tix & 63, gw = blockIdx.x * (NTHR / 64) + (tix >> 6), nw = gridDim.x * (NTHR / 64);
    f32x4 gv[8];
#pragma unroll
    for (int i = 0; i < 8; ++i) gv[i] = *(const f32x4*)(p.final_g + (i * 64 + lane) * 4);
    for (int r = gw; r < NBATCH * SEQ; r += nw) {
        float* row = p.out + (size_t)r * DM;
        f32x4 v[8];
        float ss = 0.f;
#pragma unroll
        for (int i = 0; i < 8; ++i) { v[i] = *(const f32x4*)(row + (i * 64 + lane) * 4); ss += v[i][0] * v[i][0] + v[i][1] * v[i][1] + v[i][2] * v[i][2] + v[i][3] * v[i][3]; }
        ss = wsum(ss);
        const float rinv = rsqrtf(ss * (1.f / DM) + 1e-6f);
#pragma unroll
        for (int i = 0; i < 8; ++i) *(f32x4*)(row + (i * 64 + lane) * 4) = v[i] * rinv * gv[i];
    }
}

DI void phase_inproj0(const P& p, char* shm) {
    const char* H = p.ws + O_H;
    const char* W = p.ws + O_WIN0;
    const int nM = NROW / 256, nN = 10;
    auto get = [&](int i, Unit& u) {
        const long L = (long)i * gridDim.x + blockIdx.x;
        if (L >= nM * nN) return false;
        tile_of((int)L, nM, nN, u.pm, u.pn);
        const char* hp = H + (size_t)u.pm * 256 * DM * 2;
        const char* wp = W + (size_t)u.pn * 256 * DM * 2;
        const bool tr = u.pn == 5;
        u.A = tr ? wp : hp; u.B = tr ? hp : wp;
        return true;
    };
    auto epi = [&](const Acc& acc, const Unit& u) {
        const int brow = u.pm * 256, pn = u.pn;
        if (pn == 5) epi_T<64>(acc, 0, brow, (bf16_t*)(p.ws + O_VAT), 256, nullptr);
        else if (pn < 4) epi_rope<128>(acc, p, brow, (bf16_t*)(p.ws + O_QA), 1024, pn * 256, 128, nullptr, 2);
        else if (pn == 4) epi_rope<128>(acc, p, brow, (bf16_t*)(p.ws + O_KA), 256, 0, 128, nullptr, 2);
        else if (pn < 8) epi_plain(acc, brow, (bf16_t*)(p.ws + O_QLAT), 512, (pn - 6) * 256, nullptr);
        else if (pn == 8) epi_plain(acc, brow, (bf16_t*)(p.ws + O_KVLAT), 256, 0, nullptr);
        else epi_rope<64>(acc, p, brow, (bf16_t*)(p.ws + O_KR), 64, 0, 64, nullptr, 1);
    };
    gemm_stream((LAS unsigned char*)shm, DM, DM, get, epi);
}
template <int W>
DI void row_rms(const bf16_t* src, int row0, float* rs) {
    const int tid = tidx(), r = tid >> 1, hf = tid & 1;
    const bf16_t* q = src + (size_t)(row0 + r) * W + hf * (W / 2);
    float ss = 0.f;
#pragma unroll 4
    for (int i = 0; i < W / 16; ++i) {
        const bf16x8 v = *(const bf16x8*)(q + i * 8);
#pragma unroll
        for (int e = 0; e < 8; ++e) { const float f = bf2f((unsigned short)v[e]); ss += f * f; }
    }
    ss += __shfl_xor(ss, 1);
    if (hf == 0) rs[r] = rsqrtf(ss * (1.f / W) + 1e-6f);
    __syncthreads();
}
DI void phase_qkvb(const P& p, char* shm) {
    float* rs = (float*)(shm + 131072);
    Acc acc;
    const int nM = NROW / 256;
    const int total = nM * 6 + nM * 8;
    for (int L = blockIdx.x; L < total; L += gridDim.x) {
        const bool isq = L < nM * 6;
        int pm, pn;
        if (isq) tile_of(L, nM, 6, pm, pn); else tile_of(L - nM * 6, nM, 8, pm, pn);
        const int brow = pm * 256;
        if (isq) row_rms<512>((const bf16_t*)(p.ws + O_QLAT), brow, rs); else row_rms<256>((const bf16_t*)(p.ws + O_KVLAT), brow, rs);
        const bf16_t* Aact = (const bf16_t*)(p.ws + (isq ? O_QLAT : O_KVLAT));
        const bf16_t* Wt = (const bf16_t*)(p.ws + (isq ? O_WQB : O_WKVB));
        const bool tr = !isq && pn >= 4;
        gemm_tile(tr ? Wt : Aact, tr ? Aact : Wt, isq ? 512 : 256, tr ? pn * 256 : brow, tr ? brow : pn * 256, (LAS unsigned char*)shm, acc);
        if (isq) {
            if (pn < 4) {
                EPI_IDX
#pragma unroll
                for (int ai = 0; ai < 2; ++ai)
#pragma unroll
                    for (int m = 0; m < 4; ++m) {
                        const int lr = ai * 128 + wr * 64 + m * 16 + fr;
                        const float s = rs[lr];
#pragma unroll
                        for (int bj = 0; bj < 2; ++bj)
#pragma unroll
                            for (int n = 0; n < 2; ++n) {
                                const f32x4 v = acc[ai][bj][m][n];
                                st4((bf16_t*)(p.ws + O_QM) + (size_t)(brow + lr) * 1536 + (pn * 2 + bj) * 192 + wc * 32 + n * 16 + fq * 4, v[0] * s, v[1] * s, v[2] * s, v[3] * s);
                            }
                    }
                EPI_DONE;
            } else {
                epi_rope<64>(acc, p, brow, (bf16_t*)(p.ws + O_QM), 1536, (pn - 4) * 4 * 192 + 128, 192, rs, 4);
            }
        } else if (!tr) {
            epi_plain(acc, brow, (bf16_t*)(p.ws + O_KN), 1024, pn * 256, rs);
        } else {
            epi_T<64>(acc, (pn - 4) * 256, brow, (bf16_t*)(p.ws + O_VMT), 1024, rs);
        }
        __syncthreads();
    }
}
DI int brow_of(int pm, bool lat_only) { return lat_only ? (pm >> 4) * PB + CTXL + (pm & 15) * 256 : pm * 256; }
DI void phase_gemm_resid(const P& p, char* shm, const char* A, const char* W, int K, int layer, int gch, bool from_input, bool lat_only, bool a_lat) {
    const int nM = lat_only ? NBATCH * SEQ / 256 : NROW / 256, nN = DM / 256;
    auto get = [&](int i, Unit& u) {
        const long L = (long)i * gridDim.x + blockIdx.x;
        if (L >= nM * nN) return false;
        tile_of((int)L, nM, nN, u.pm, u.pn);
        const int arow = a_lat ? u.pm * 256 : brow_of(u.pm, lat_only);
        u.A = A + (size_t)arow * K * 2;
        u.B = W + (size_t)u.pn * 256 * K * 2;
        return true;
    };
    auto epi = [&](const Acc& acc, const Unit& u) { epi_resid(acc, p, brow_of(u.pm, lat_only), u.pn * 256, layer, gch, from_input); };
    gemm_stream((LAS unsigned char*)shm, K, K, get, epi);
}
DI void phase_gemm_resid_ctx(const P& p, char* shm, const char* A, const char* W, int K, int S) {
    const int nN = DM / 256, Kl = K / S, total = 4 * nN * S;
    auto get = [&](int i, Unit& u) {
        const long L = (long)i * gridDim.x + blockIdx.x;
        if (L >= total) return false;
        const int sl = (int)L % S, t = (int)L / S;
        u.pm = (t / nN) * 17; u.pn = (t % nN) + 16 * sl;
        u.A = A + ((size_t)u.pm * 256 * K + (size_t)sl * Kl) * 2;
        u.B = W + ((size_t)(t % nN) * 256 * K + (size_t)sl * Kl) * 2;
        return true;
    };
    auto epi = [&](const Acc& acc, const Unit& u) { epi_part(acc, p, u.pm * 256, (u.pn & 15) * 256, u.pn >> 4); };
    gemm_stream((LAS unsigned char*)shm, Kl, K, get, epi);
}
DI void phase_ffn1(const P& p, char* shm, const char* H, const char* W, bf16_t* hid, bool lat_only) {
    const int nM = lat_only ? NBATCH * SEQ / 256 : NROW / 256, nN = 2 * FF / 256;
    auto get = [&](int i, Unit& u) {
        const long L = (long)i * gridDim.x + blockIdx.x;
        if (L >= nM * nN) return false;
        tile_of((int)L, nM, nN, u.pm, u.pn);
        u.A = H + (size_t)brow_of(u.pm, lat_only) * DM * 2;
        u.B = W + (size_t)u.pn * 256 * DM * 2;
        return true;
    };
    auto epi = [&](const Acc& acc, const Unit& u) { epi_swiglu(acc, brow_of(u.pm, lat_only), u.pn, hid); };
    gemm_stream((LAS unsigned char*)shm, DM, DM, get, epi);
}
DI void phase_inproj1(const P& p, char* shm) {
    const char* H = p.ws + O_H;
    const char* W = p.ws + O_WIN1;
    auto get = [&](int i, Unit& u) {
        const long L = (long)i * gridDim.x + blockIdx.x;
        if (L >= 3072 + 96) return false;
        if (L < 3072) { int pm; tile_of((int)L, 64, 48, pm, u.pn); u.pm = (pm >> 4) * 17 + 1 + (pm & 15); }
        else { const int j = (int)L - 3072; u.pm = (j / 24) * 17; u.pn = 8 + j % 24; }
        const char* hp = H + (size_t)u.pm * 256 * DM * 2;
        const char* wp = W + (size_t)u.pn * 256 * DM * 2;
        const bool tr = u.pn >= 16 && u.pn < 32;
        u.A = tr ? wp : hp; u.B = tr ? hp : wp;
        return true;
    };
    auto epi = [&](const Acc& acc, const Unit& u) {
        const int brow = u.pm * 256, pn = u.pn;
        const int b = u.pm / 17, pt = u.pm % 17;
        const size_t latrow0 = (size_t)b * SEQ + (pt - 1) * 256;
        if (pn < 8) epi_rope256(acc, p, brow, (bf16_t*)(p.ws + O_Q1), latrow0, pn * 256, 1.f);
        else if (pn < 16) epi_rope256(acc, p, brow, (bf16_t*)(p.ws + O_K1), (size_t)brow, (pn - 8) * 256, 0.0625f);
        else if (pn < 32) epi_T<32>(acc, (pn - 16) * 256, brow, (bf16_t*)(p.ws + O_V1T), 4096, nullptr);
        else epi_plain(acc, 0, (bf16_t*)(p.ws + O_G1) + latrow0 * 4096, 4096, (pn - 32) * 256, nullptr);
    };
    gemm_stream((LAS unsigned char*)shm, DM, DM, get, epi);
}

template <int DQK, bool SWA>
DI void attn_item(const P& p, char* shm, int b, int head, int qtile) {
    const int tid = tidx(), wid = tid >> 6, lane = tid & 63, l31 = lane & 31, hh = lane >> 5;
    constexpr int KST = DQK * 2 + 16, VST = 136  , NKC = DQK / 8;
    char* Ks = shm;
    char* Vs = shm + 64 * KST;
    const bf16_t* QA = (const bf16_t*)(p.ws + O_QA);
    const bf16_t* QM = (const bf16_t*)(p.ws + O_QM);
    const bf16_t* KA = (const bf16_t*)(p.ws + O_KA);
    const bf16_t* KN = (const bf16_t*)(p.ws + O_KN);
    const bf16_t* KR = (const bf16_t*)(p.ws + O_KR);
    const bf16_t* VT = (const bf16_t*)(p.ws + (SWA ? O_VAT : O_VMT));
    const int qp0 = qtile == 0 ? 0 : CTXL + (qtile - 1) * 256;
    const int myp = qp0 + wid * 32 + l31;
    const size_t qrow = (size_t)b * PB + myp;
    bf16x8 qf[DQK / 16];
    {
        const bf16_t* qptr = SWA ? QA + qrow * 1024 + head * 128 : QM + qrow * 1536 + head * 192;
#pragma unroll
        for (int s = 0; s < DQK / 16; ++s) qf[s] = *(const bf16x8*)(qptr + 16 * s + 8 * hh);
    }
    int lo = 0, hi = 0;
    if (qtile > 0) {
        if (SWA) { const int q0 = (qtile - 1) * 256; lo = (q0 - 128 < 0 ? 0 : q0 - 128) / 64; hi = (q0 + 384 > SEQ ? SEQ : q0 + 384) / 64; }
        else { lo = 0; hi = SEQ / 64; }
    }
    const int ntiles = 4 + (hi - lo);
    const int kvh = SWA ? head >> 2 : head;
    const int nhv = SWA ? 2 : 8;
    float mrun, lrun;
    if (SWA) { mrun = p.sink[head] * LOG2E; lrun = 1.f; } else { mrun = -1e30f; lrun = 0.f; }
    const float sl2 = (SWA ? 0.08838834764831845f : 0.07216878364870323f) * LOG2E;
    f32x16 oT[4];
#pragma unroll
    for (int v = 0; v < 4; ++v)
#pragma unroll
        for (int r = 0; r < 16; ++r) oT[v][r] = 0.f;
    constexpr int NKL = (64 * NKC) / NTHR;
    bf16x8 kreg[NKL], vreg[2];
    auto kp_of = [&](int t) { return t < 4 ? 64 * t : CTXL + 64 * (lo + t - 4); };
    const int kc0 = tid, kc1 = tid + NTHR;
    const int kld = SWA ? 256 : 1024;
    const int koff0 = (kc0 >> 4) * kld + (kc0 & 15) * 8, koff1 = (kc1 >> 4) * kld + (kc1 & 15) * 8, koff2 = tid * 8;
    const int klds0 = (kc0 >> 4) * KST + (kc0 & 15) * 16, klds1 = (kc1 >> 4) * KST + (kc1 & 15) * 16, klds2 = (tid >> 3) * KST + (16 + (tid & 7)) * 16;
    const int vlds0 = (kc0 >> 3) * VST + (kc0 & 7) * 16, vlds1 = (kc1 >> 3) * VST + (kc1 & 7) * 16;
    auto load_tile = [&](int t) {
        const int kp0 = kp_of(t);
        const size_t ur0 = (size_t)b * PB + kp0;
        if (SWA) {
            const bf16_t* kb = KA + ur0 * 256 + kvh * 128;
            kreg[0] = *(const bf16x8*)(kb + koff0);
            kreg[1] = *(const bf16x8*)(kb + koff1);
        } else {
            const bf16_t* kb = KN + ur0 * 1024 + head * 128;
            kreg[0] = *(const bf16x8*)(kb + koff0);
            kreg[1] = *(const bf16x8*)(kb + koff1);
            kreg[NKL - 1] = *(const bf16x8*)(KR + ur0 * 64 + koff2);
        }
        const bf16_t* vb_ = VT + (((size_t)b * (PB / 64) + (kp0 >> 6)) * (nhv * 128) + kvh * 128) * 64;
        vreg[0] = *(const bf16x8*)(vb_ + kc0 * 8);
        vreg[1] = *(const bf16x8*)(vb_ + kc1 * 8);
    };
    auto store_tile = [&](int t) {
        const int bo = (t & 1) * (64 * KST + 128 * VST);
        *(bf16x8*)(Ks + bo + klds0) = kreg[0];
        *(bf16x8*)(Ks + bo + klds1) = kreg[1];
        if (!SWA) *(bf16x8*)(Ks + bo + klds2) = kreg[NKL - 1];
#pragma unroll
        for (int i = 0; i < 2; ++i) {
            const s16x4 w0 = __builtin_shufflevector(vreg[i], vreg[i], 0, 1, 2, 3), w1 = __builtin_shufflevector(vreg[i], vreg[i], 4, 5, 6, 7);
            char* dstv = Vs + bo + (i ? vlds1 : vlds0);
            *(s16x4*)dstv = w0;
            *(s16x4*)(dstv + 8) = w1;
        }
    };
    constexpr int TB = 64 * KST + 128 * VST;
    load_tile(0);
    store_tile(0);
    load_tile(1);
    __syncthreads();
    for (int t = 0; t < ntiles; ++t) {
        const char* Kb = Ks + (t & 1) * TB;
        const char* Vb = Vs + (t & 1) * TB;
        f32x16 sT[2];
#pragma unroll
        for (int kb = 0; kb < 2; ++kb)
#pragma unroll
            for (int r = 0; r < 16; ++r) sT[kb][r] = 0.f;
        {
            constexpr int NG = DQK / 32;
            const char* kl = Kb + l31 * KST + 16 * hh;
            bf16x8 ka[3][4];
#pragma unroll
            for (int g0 = 0; g0 < 2; ++g0)
#pragma unroll
                for (int i = 0; i < 4; ++i) ka[g0][i] = *(const bf16x8*)(kl + (i & 1) * 32 * KST + 32 * (2 * g0 + (i >> 1)));
            __builtin_amdgcn_s_setprio(1);
#pragma unroll
            for (int g = 0; g < NG; ++g) {
                if (g + 2 < NG) {
#pragma unroll
                    for (int i = 0; i < 4; ++i) ka[(g + 2) % 3][i] = *(const bf16x8*)(kl + (i & 1) * 32 * KST + 32 * (2 * (g + 2) + (i >> 1)));
                }
                __builtin_amdgcn_sched_barrier(0);
#pragma unroll
                for (int i = 0; i < 4; ++i) sT[i & 1] = MFMA32(ka[g % 3][i], qf[2 * g + (i >> 1)], sT[i & 1]);
                __builtin_amdgcn_sched_barrier(0);
            }
            __builtin_amdgcn_s_setprio(0);
        }
        if (t + 1 < ntiles) store_tile(t + 1);
        if (t + 2 < ntiles) load_tile(t + 2);
        const bool band = SWA && t >= 4;
        const int kl0 = 64 * (lo + t - 4), qs = myp - CTXL;
        float mx = -3.0e38f;
#pragma unroll
        for (int kb = 0; kb < 2; ++kb)
#pragma unroll
            for (int r = 0; r < 16; ++r) {
                if (band) { const int dd = qs - (kl0 + kb * 32 + crow(r, hh)); if (dd > 128 || dd < -128) sT[kb][r] = -3.0e37f; }
                mx = fmaxf(mx, sT[kb][r]);
            }
        mx = fmaxf(mx, __shfl_xor(mx, 32));
        const float cand = fmaxf(mrun, mx * sl2);
        const bool grew = __any(cand - mrun > 8.f);
        const float mn = grew ? cand : mrun;
        const float alpha = __builtin_amdgcn_exp2f(mrun - mn);
        mrun = mn;
        float ls = 0.f;
#pragma unroll
        for (int kb = 0; kb < 2; ++kb)
#pragma unroll
            for (int r = 0; r < 16; ++r) { const float pv = __builtin_amdgcn_exp2f(fmaf(sT[kb][r], sl2, -mn)); sT[kb][r] = pv; ls += pv; }
        ls += __shfl_xor(ls, 32);
        lrun = lrun * alpha + ls;
        if (grew) {
#pragma unroll
            for (int v = 0; v < 4; ++v) oT[v] *= alpha;
        }
        bf16x8 pf[2][2];
#pragma unroll
        for (int kb = 0; kb < 2; ++kb)
#pragma unroll
            for (int s2 = 0; s2 < 2; ++s2)
                pf[kb][s2] = pack8(sT[kb][8 * s2], sT[kb][8 * s2 + 1], sT[kb][8 * s2 + 2], sT[kb][8 * s2 + 3], sT[kb][8 * s2 + 4], sT[kb][8 * s2 + 5], sT[kb][8 * s2 + 6], sT[kb][8 * s2 + 7]);
        {
            const char* vl = Vb + l31 * VST + 8 * hh;
            bf16x8 va[2][4];
            auto vfrag = [&](int g, int v) {
                const char* vp = vl + v * 32 * VST + 32 * g;
                const s16x4 vlo = *(const s16x4*)vp, vhi = *(const s16x4*)(vp + 16);
                return (bf16x8)__builtin_shufflevector(vlo, vhi, 0, 1, 2, 3, 4, 5, 6, 7);
            };
#pragma unroll
            for (int v = 0; v < 4; ++v) va[0][v] = vfrag(0, v);
            __builtin_amdgcn_s_setprio(1);
#pragma unroll
            for (int g = 0; g < 4; ++g) {
                if (g + 1 < 4) {
#pragma unroll
                    for (int v = 0; v < 4; ++v) va[(g + 1) & 1][v] = vfrag(g + 1, v);
                }
                __builtin_amdgcn_sched_barrier(0);
#pragma unroll
                for (int v = 0; v < 4; ++v) oT[v] = MFMA32(va[g & 1][v], pf[g >> 1][g & 1], oT[v]);
                __builtin_amdgcn_sched_barrier(0);
            }
            __builtin_amdgcn_s_setprio(0);
        }
        __syncthreads();
    }
    const float inv = 1.f / lrun;
    bf16_t* op = (bf16_t*)(p.ws + O_OCAT) + qrow * DM + (SWA ? 0 : 1024) + head * 128;
#pragma unroll
    for (int v = 0; v < 4; ++v)
#pragma unroll
        for (int g = 0; g < 4; ++g)
            st4(op + v * 32 + 8 * g + 4 * hh, oT[v][4 * g] * inv, oT[v][4 * g + 1] * inv, oT[v][4 * g + 2] * inv, oT[v][4 * g + 3] * inv);
    __syncthreads();
}
DI void phase_attn(const P& p, char* shm) {
    const int total = 512 + 512 + 32 + 32;
    for (int it = blockIdx.x; it < total; it += gridDim.x) {
        const int j0 = it & 511, rnd = (j0 >> 8) & 1, w = j0 & 255, xcd = w & 7, slot = w >> 3;
        const int grp = gridDim.x == 256 ? rnd * 16 + xcd * 2 + (slot >> 4) : j0 >> 4, qt0 = gridDim.x == 256 ? (slot & 15) : (j0 & 15);
        if (it < 512) { attn_item<192, false>(p, shm, grp >> 3, grp & 7, qt0 + 1); }
        else if (it < 1024) { attn_item<128, true>(p, shm, grp >> 3, grp & 7, qt0 + 1); }
        else if (it < 1056) { const int j = it - 1024; attn_item<192, false>(p, shm, j >> 3, j & 7, 0); }
        else { const int j = it - 1056; attn_item<128, true>(p, shm, j >> 3, j & 7, 0); }
    }
}

DI unsigned off_b(unsigned row, unsigned ch) { return 256u * row + 16u * (ch ^ (((row & 3) << 2) | ((row >> 2) & 3))); }
DI void tr_issue4(s16x4 (&r)[4], unsigned a0, unsigned a1, unsigned a2, unsigned a3) {
    asm volatile("ds_read_b64_tr_b16 %0, %4\n\tds_read_b64_tr_b16 %1, %5\n\tds_read_b64_tr_b16 %2, %6\n\tds_read_b64_tr_b16 %3, %7"
                 : "=&v"(r[0]), "=&v"(r[1]), "=&v"(r[2]), "=&v"(r[3]) : "v"(a0), "v"(a1), "v"(a2), "v"(a3) : "memory");
}
template <int N>
DI void tr_wait4(s16x4 (&r)[4]) {
    asm volatile("s_waitcnt lgkmcnt(%4)" : "+v"(r[0]), "+v"(r[1]), "+v"(r[2]), "+v"(r[3]) : "n"(N) : "memory");
}
constexpr int SC_QST = 528  , SC_Q = 0, SC_K = 32 * SC_QST, SC_V = SC_K + 16384, SC_VS = SC_V + 10240, SC_VST = 80, SC_BUF = SC_VS + 10240, SC_X = 2 * SC_BUF  ;
#define PACK16(x, s2) pack8(x[8 * (s2)], x[8 * (s2) + 1], x[8 * (s2) + 2], x[8 * (s2) + 3], x[8 * (s2) + 4], x[8 * (s2) + 5], x[8 * (s2) + 6], x[8 * (s2) + 7])
DI void scan_item(const P& p, char* shm, int item) {
    const int tid = tidx(), wid = __builtin_amdgcn_readfirstlane(tid >> 6);
    const int b = item >> 6, h = (item >> 3) & 7, dir = (item >> 2) & 1, vs = item & 3;
    const int vb = wid & 3, dh = wid >> 2;
    const bf16_t* Q1 = (const bf16_t*)(p.ws + O_Q1);
    const bf16_t* K1 = (const bf16_t*)(p.ws + O_K1);
    const bf16_t* V1T = (const bf16_t*)(p.ws + O_V1T);
    bf16_t* OX = (bf16_t*)(p.ws + (dir ? O_OB : O_OF));
    const float logit = (dir ? p.lb : p.lf)[h];
    const float lg2 = -log1pf(__expf(-logit)) * LOG2E;
    const int nsteps = PB / 32;
    auto p0_of = [&](int s) { return dir == 0 ? 32 * s : (s < 8 ? 224 - 32 * s : PB - 32 - 32 * (s - 8)); };
    const int lane_c = tid & 63, l31_c = lane_c & 31, hh_c = lane_c >> 5;
    const int ld_row0 = tid >> 5, ld_ch32 = tid & 31;
    const int koff = ld_row0 * DM + ld_ch32 * 8;
    const unsigned ldsK0 = (ld_ch32 >> 4) * 8192 + off_b(ld_row0, ld_ch32 & 15), ldsK1 = (ld_ch32 >> 4) * 8192 + off_b(ld_row0 + 16, ld_ch32 & 15);
    const unsigned ldsQ0 = ld_row0 * SC_QST + ld_ch32 * 16, ldsQ1 = ldsQ0 + 16 * SC_QST;
    const int voff = (tid >> 2) * 32 + (tid & 3) * 8;
    const unsigned ldsV = (tid >> 2) * SC_VST + (tid & 3) * 16;
    const unsigned xrow_c = ((l31_c & 3) << 2) | ((l31_c >> 2) & 3);
    const unsigned Lrow = 256u * l31_c + 16u * xrow_c;
    const unsigned Lrd_c = Lrow ^ (16u * hh_c);
    const unsigned q4_c = (lane_c & 15) >> 2, pp_c = lane_c & 3, u_c = 2 * ((lane_c >> 4) & 1) + (pp_c >> 1);
    const unsigned Ltr_c = 256u * (8u * hh_c + q4_c) + 8u * (pp_c & 1) + 64u * q4_c + 16u * (u_c ^ (2u * hh_c));
    const unsigned vrow_c = (vb * 32 + l31_c) * SC_VST;
    const unsigned qrow_c = l31_c * SC_QST + 8u * hh_c;
    const int flane = hh_c * 4 * 4096 + l31_c;
    bf16x8 kq[2], qq[2], vv;
    auto issue_chunk = [&](int s) {
        const int p0 = p0_of(s);
        const bool lat = p0 >= CTXL;
        const bf16_t* kp = K1 + ((size_t)b * PB + p0) * DM + h * 256;
        const bf16_t* qp = Q1 + ((size_t)b * SEQ + (p0 - CTXL)) * DM + h * 256;
        const bf16_t* vp = V1T + (((size_t)b * (PB / 32) + (p0 >> 5)) * 4096 + h * 512 + vs * 128) * 32;
        kq[0] = *(const bf16x8*)(kp + koff);
        kq[1] = *(const bf16x8*)(kp + koff + 16 * DM);
        if (lat) { qq[0] = *(const bf16x8*)(qp + koff); qq[1] = *(const bf16x8*)(qp + koff + 16 * DM); }
        vv = *(const bf16x8*)(vp + voff);
    };
    auto store_chunk = [&](int s) {
        char* buf = shm + (s & 1) * SC_BUF;
        const bool lat = p0_of(s) >= CTXL;
        *(bf16x8*)(buf + SC_K + ldsK0) = kq[0];
        *(bf16x8*)(buf + SC_K + ldsK1) = kq[1];
        if (lat) { *(bf16x8*)(buf + SC_Q + ldsQ0) = qq[0]; *(bf16x8*)(buf + SC_Q + ldsQ1) = qq[1]; }
        *(bf16x8*)(buf + SC_V + ldsV) = vv;
        float f[8];
#pragma unroll
        for (int e = 0; e < 8; ++e) {
            const int j = (tid & 3) * 8 + e;
            f[e] = bf2f((unsigned short)vv[e]) * __builtin_amdgcn_exp2f(lg2 * (float)(dir == 0 ? 31 - j : j));
        }
        *(bf16x8*)(buf + SC_VS + ldsV) = pack8(f[0], f[1], f[2], f[3], f[4], f[5], f[6], f[7]);
    };
    f32x16 st[4];
#pragma unroll
    for (int d = 0; d < 4; ++d)
#pragma unroll
        for (int r = 0; r < 16; ++r) st[d][r] = 0.f;
    f32x16 oprev;
#pragma unroll
    for (int r = 0; r < 16; ++r) oprev[r] = 0.f;
    int pprev = -1;
    const float cdec = __builtin_amdgcn_exp2f(lg2 * 32.f);
    auto flush_prev = [&](int sprev) {
        const float* xp = (const float*)(shm + SC_X + (sprev & 1) * 16384 + vb * 4096) + lane_c * 16;
        bf16_t* ob = OX + ((size_t)b * SEQ + pprev) * 4096 + h * 512 + vs * 128 + vb * 32;
        const __amdgpu_buffer_rsrc_t rs = __builtin_amdgcn_make_buffer_rsrc(ob, 0, 0x7fffffff, 0x00020000);
#pragma unroll
        for (int g = 0; g < 4; ++g) {
            const f32x4 x = *(const f32x4*)(xp + 4 * g);
#pragma unroll
            for (int j = 0; j < 4; ++j)
                __builtin_amdgcn_raw_buffer_store_b16((short)(pk2(oprev[4 * g + j] + x[j], 0.f) & 0xffffu), rs, flane * 2, (j + 8 * g) * 8192, 0);
        }
    };
    float dmask[16];
    float qlane;
    {
#pragma unroll
        for (int r = 0; r < 16; ++r) {
            const int j = crow(r, hh_c);
            const int dd = dir == 0 ? l31_c - j : j - l31_c;
            dmask[r] = dd >= 0 ? __builtin_amdgcn_exp2f(lg2 * (float)dd) : 0.f;
        }
        qlane = __builtin_amdgcn_exp2f(lg2 * (float)(dir == 0 ? 1 + 4 * hh_c : 32 - 4 * hh_c));
    }
    const float lgs = dir == 0 ? lg2 : -lg2;
    issue_chunk(0); store_chunk(0); issue_chunk(1);
    __syncthreads();
    for (int s = 0; s < nsteps; ++s) {
        if (dh == 0 && pprev >= 0) { flush_prev(s - 1); pprev = -1; }
        const int lane = lane_c, l31 = l31_c, hh = hh_c;
        unsigned Lrd = Lrd_c, Ltr = Ltr_c, vrow = vrow_c, qrow = qrow_c;
        asm volatile("" : "+v"(Lrd), "+v"(Ltr), "+v"(vrow), "+v"(qrow));
        const char* buf = shm + (s & 1) * SC_BUF;
        const char* kimg = buf + SC_K + dh * 8192;
        const char* qimg = buf + SC_Q + dh * 256 + qrow;
        const int p0 = p0_of(s);
        if (p0 >= CTXL) {
            f32x16 pT;
#pragma unroll
            for (int r = 0; r < 16; ++r) pT[r] = 0.f;
#pragma unroll
            for (int s8 = 0; s8 < 8; ++s8) {
                const unsigned o = Lrd ^ (32u * s8);
                const bf16x8 a = *(const bf16x8*)(kimg + o);
                const bf16x8 bq = *(const bf16x8*)(qimg + 8 * hh + 32 * s8);
                pT = MFMA32(a, bq, pT);
            }
#pragma unroll
            for (int r = 0; r < 16; ++r) pT[r] *= dmask[r];
            bf16x8 pfr[2];
            pfr[0] = PACK16(pT, 0);
            pfr[1] = PACK16(pT, 1);
            f32x16 o;
#pragma unroll
            for (int r = 0; r < 16; ++r) o[r] = 0.f;
#pragma unroll
            for (int db = 0; db < 4; ++db)
#pragma unroll
                for (int s2 = 0; s2 < 2; ++s2) {
                    const bf16x8 bfrag = PACK16(st[db], s2);
                    const s16x4 qlo = *(const s16x4*)(qimg + db * 64 + 32 * s2), qhi = *(const s16x4*)(qimg + db * 64 + 32 * s2 + 16);
                    const bf16x8 a2 = __builtin_shufflevector(qlo, qhi, 0, 1, 2, 3, 4, 5, 6, 7);
                    o = MFMA32(a2, bfrag, o);
                }
#pragma unroll
            for (int r = 0; r < 16; ++r) o[r] *= qlane * __builtin_amdgcn_exp2f(lgs * (float)((r & 3) + 8 * (r >> 2)));
#pragma unroll
            for (int s2 = 0; s2 < 2; ++s2) {
                const char* vp = buf + SC_V + vrow + 8 * hh + 32 * s2;
                const s16x4 vlo = *(const s16x4*)vp, vhi = *(const s16x4*)(vp + 16);
                const bf16x8 b3 = __builtin_shufflevector(vlo, vhi, 0, 1, 2, 3, 4, 5, 6, 7);
                o = MFMA32(pfr[s2], b3, o);
            }
            if (dh == 1) {
                float* xp = (float*)(shm + SC_X + (s & 1) * 16384 + vb * 4096) + lane * 16;
#pragma unroll
                for (int g = 0; g < 4; ++g) *(f32x4*)(xp + 4 * g) = (f32x4){o[4 * g], o[4 * g + 1], o[4 * g + 2], o[4 * g + 3]};
            } else {
                oprev = o;
                pprev = p0 - CTXL;
            }
            __builtin_amdgcn_sched_barrier(0);
        }
        if (s + 1 < nsteps) store_chunk(s + 1);
        if (s + 2 < nsteps) issue_chunk(s + 2);
        {
            const unsigned ka = (unsigned)(size_t)kimg;
            const char* vsp = buf + SC_VS + vrow + 16 * hh;
            const bf16x8 bv0 = *(const bf16x8*)(vsp), bv1 = *(const bf16x8*)(vsp + 32);
            s16x4 tr[2][4];
            tr_issue4(tr[0], ka + Ltr, ka + 1024u + (Ltr ^ 16u), ka + 4096u + Ltr, ka + 5120u + (Ltr ^ 16u));
#pragma unroll
            for (int db = 0; db < 4; ++db) {
                if (db < 3) {
                    const unsigned cx = 64u * (db + 1);
                    tr_issue4(tr[(db + 1) & 1], ka + (Ltr ^ cx), ka + 1024u + (Ltr ^ (cx + 16u)), ka + 4096u + (Ltr ^ cx), ka + 5120u + (Ltr ^ (cx + 16u)));
                    tr_wait4<4>(tr[db & 1]);
                } else {
                    tr_wait4<0>(tr[db & 1]);
                }
                st[db] *= cdec;
#pragma unroll
                for (int ks = 0; ks < 2; ++ks) {
                    const bf16x8 a = __builtin_shufflevector(tr[db & 1][2 * ks], tr[db & 1][2 * ks + 1], 0, 1, 2, 3, 4, 5, 6, 7);
                    st[db] = MFMA32(a, ks ? bv1 : bv0, st[db]);
                }
            }
        }
        __syncthreads();
    }
    if (dh == 0 && pprev >= 0) flush_prev(nsteps - 1);
    __syncthreads();
}

DI void phase_gn(const P& p, char* shm) {
    const int tix = tidx(), lane = tix & 63, gw = blockIdx.x * (NTHR / 64) + (tix >> 6), nw = gridDim.x * (NTHR / 64);
    const bf16_t* OF = (const bf16_t*)(p.ws + O_OF);
    const bf16_t* OB = (const bf16_t*)(p.ws + O_OB);
    const bf16_t* G1 = (const bf16_t*)(p.ws + O_G1);
    bf16_t* AG = (bf16_t*)(p.ws + O_OF);
    for (int r = gw; r < NBATCH * SEQ; r += nw) {
        const size_t o0 = (size_t)r * 4096 + lane * 8;
#pragma unroll
        for (int hh4 = 0; hh4 < 2; ++hh4) {
            bf16x8 a[4], bq[4], gq[4];
#pragma unroll
            for (int k = 0; k < 4; ++k) {
                const size_t o = o0 + (hh4 * 4 + k) * 512;
                a[k] = *(const bf16x8*)(OF + o); bq[k] = *(const bf16x8*)(OB + o); gq[k] = *(const bf16x8*)(G1 + o);
            }
            __builtin_amdgcn_sched_barrier(0);
#pragma unroll
            for (int k = 0; k < 4; ++k) {
                float v[8], s = 0.f;
#pragma unroll
                for (int e = 0; e < 8; ++e) { v[e] = bf2f((unsigned short)a[k][e]) + bf2f((unsigned short)bq[k][e]); s += v[e]; }
                const float mu = wsum(s) * (1.f / 512.f);
                float q = 0.f;
#pragma unroll
                for (int e = 0; e < 8; ++e) { v[e] -= mu; q += v[e] * v[e]; }
                const float rinv = rsqrtf(wsum(q) * (1.f / 512.f) + 1e-6f);
                float y[8];
#pragma unroll
                for (int e = 0; e < 8; ++e) { const float g = bf2f((unsigned short)gq[k][e]); y[e] = silu_f(g) * (v[e] * rinv); }
                *(bf16x8*)(AG + o0 + (hh4 * 4 + k) * 512) = pack8(y[0], y[1], y[2], y[3], y[4], y[5], y[6], y[7]);
                __builtin_amdgcn_sched_barrier(0);
            }
        }
    }
    __syncthreads();
    int base = 0;
    conv_job(p.ret_w_out, nullptr, p.gn_g, (bf16_t*)(p.ws + O_WOUT1), 4096, DM, DM, CK_NAT, base, shm);
    conv_job(p.w_gate + (size_t)DM * FF, p.w_up + (size_t)DM * FF, nullptr, (bf16_t*)(p.ws + O_WGU1), DM, FF, 2 * FF, CK_GU, base, shm);
    conv_job(p.w_down + (size_t)FF * DM, nullptr, nullptr, (bf16_t*)(p.ws + O_WDN1), FF, DM, DM, CK_NAT, base, shm);
}


#define XB_TMO      128
#define XB_XCNT(j)  (256  + 64 * (j))
#define XB_XSUB(j)  (1280 + 64 * (j))
#define XB_XGEN(j)  (2304 + 64 * (j))
#define XB_TOP      3328
#define XB_TOPGEN   3392
#define XCD_BAR_WORDS 3456
#define XB_SPIN_CAP (1u << 18)
DI unsigned xb_ld(unsigned* p) { return __hip_atomic_load(p, __ATOMIC_RELAXED, __HIP_MEMORY_SCOPE_AGENT); }
DI unsigned xb_add(unsigned* p, unsigned v) { return __hip_atomic_fetch_add(p, v, __ATOMIC_RELAXED, __HIP_MEMORY_SCOPE_AGENT); }
DI unsigned xb_xcc_id() { return (unsigned)__builtin_amdgcn_s_getreg((3 << 11) | 20) & 0xFu; }
#define XB_SPIN(cond, bar) do { unsigned _sp = 0; while (cond) { __builtin_amdgcn_s_sleep(1); \
    if ((++_sp & 255u) == 0u) { if (xb_ld(&(bar)[XB_TMO])) break; if (_sp > XB_SPIN_CAP) { atomicAdd(&(bar)[XB_TMO], 1u); break; } } } } while (0)
struct XcdBarrier { unsigned* bar; unsigned x; volatile LAS unsigned* st; };
DI XcdBarrier xcd_barrier_post(unsigned* bar, volatile LAS unsigned* st) {
    XcdBarrier b; b.bar = bar; b.x = xb_xcc_id(); b.st = st;
    if (threadIdx.x == 0) (void)xb_add(&bar[XB_XCNT(b.x)], 1u);
    return b;
}
DI void xcd_barrier_complete(unsigned* bar, unsigned x, unsigned& nloc, unsigned& nx) {
    const unsigned G = gridDim.x * gridDim.y * gridDim.z;
    unsigned sum, cnt, mine, sp = 0u;
    for (;;) {
        sum = 0u; cnt = 0u; mine = 0u;
#pragma unroll
        for (unsigned j = 0; j < 16; ++j) { const unsigned c = xb_ld(&bar[XB_XCNT(j)]); sum += c; cnt += (c > 0u) ? 1u : 0u; mine = (j == x) ? c : mine; }
        if (sum == G) break;
        __builtin_amdgcn_s_sleep(1);
        if ((++sp & 255u) == 0u) { if (xb_ld(&bar[XB_TMO])) break; if (sp > XB_SPIN_CAP) { atomicAdd(&bar[XB_TMO], 1u); break; } }
    }
    nloc = mine > 0u ? mine : 1u; nx = cnt > 0u ? cnt : 1u;
}
DI void xcd_barrier(const XcdBarrier& b) {
    asm volatile("s_waitcnt vmcnt(0)" ::: "memory");
    __syncthreads();
    if (threadIdx.x == 0) {
        unsigned* bar = b.bar;
        __builtin_amdgcn_s_waitcnt(0);
        unsigned nloc = b.st[0], nx = b.st[1];
        if (nloc == 0u) { xcd_barrier_complete(bar, b.x, nloc, nx); b.st[0] = nloc; b.st[1] = nx; }
        const unsigned old = xb_add(&bar[XB_XSUB(b.x)], 1u);
        const unsigned gen = old / nloc;
        if (old + 1u == (gen + 1u) * nloc) {
            __builtin_amdgcn_fence(__ATOMIC_RELEASE, "agent");
            asm volatile("s_waitcnt vmcnt(0)" ::: "memory");
            const unsigned og = xb_add(&bar[XB_TOP], 1u);
            const unsigned tg = og / nx;
            if (og + 1u == (tg + 1u) * nx) xb_add(&bar[XB_TOPGEN], 1u);
            else XB_SPIN(xb_ld(&bar[XB_TOPGEN]) == tg, bar);
            __builtin_amdgcn_fence(__ATOMIC_ACQUIRE, "agent");
            xb_add(&bar[XB_XGEN(b.x)], 1u);
            asm volatile("s_waitcnt vmcnt(0)" ::: "memory");
        } else {
            XB_SPIN(xb_ld(&bar[XB_XGEN(b.x)]) == gen, bar);
            __builtin_amdgcn_fence(__ATOMIC_ACQUIRE, "agent");
            asm volatile("s_waitcnt vmcnt(0)" ::: "memory");
        }
    }
    __syncthreads();
}

#ifndef PHMASK
#define PHMASK 0xFFFFFF
#endif
__global__ void __launch_bounds__(NTHR) fwd_megakernel(P p) {
    extern __shared__ __attribute__((aligned(16))) char shm[];
    cg::grid_group grid = cg::this_grid();
    __shared__ uint4 xb_words;
    if (threadIdx.x == 0) xb_words = make_uint4(0u, 0u, 0u, 0u);
    __syncthreads();
    (void)xcd_barrier_post((unsigned*)(p.ws + O_BAR), (volatile LAS unsigned*)&xb_words);
#define GSYNC() do { XcdBarrier xb_; xb_.bar = (unsigned*)(p.ws + O_BAR); xb_.x = xb_xcc_id(); xb_.st = (volatile LAS unsigned*)&xb_words; xcd_barrier(xb_); } while (0)
#if (PHMASK >> 0) & 1
    phase0(p, shm);
#endif
    grid.sync();
#if (PHMASK >> 1) & 1
    phase_norm(p, 0, 0, true, (bf16_t*)(p.ws + O_H), false, 0, 0, 0);
#endif
    GSYNC();
#if (PHMASK >> 2) & 1
    phase_inproj0(p, shm);
#endif
    GSYNC();
#if (PHMASK >> 3) & 1
    phase_qkvb(p, shm);
#endif
    GSYNC();
#if (PHMASK >> 4) & 1
    phase_attn(p, shm);
#endif
    GSYNC();
#if (PHMASK >> 5) & 1
    phase_gemm_resid(p, shm, p.ws + O_OCAT, p.ws + O_WOUT0, DM, 0, 2, true, true, false);
    phase_gemm_resid_ctx(p, shm, p.ws + O_OCAT, p.ws + O_WOUT0, DM, 8);
#endif
    GSYNC();
#if (PHMASK >> 6) & 1
    phase_norm(p, 0, 1, false, (bf16_t*)(p.ws + O_H), false, 8, 0, 2);
#endif
    GSYNC();
#if (PHMASK >> 7) & 1
    phase_ffn1(p, shm, p.ws + O_H, p.ws + O_WGU0, (bf16_t*)(p.ws + O_HID0), false);
#endif
    GSYNC();
#if (PHMASK >> 8) & 1
    phase_gemm_resid(p, shm, p.ws + O_HID0, p.ws + O_WDN0, FF, 0, 5, false, true, false);
    phase_gemm_resid_ctx(p, shm, p.ws + O_HID0, p.ws + O_WDN0, FF, 11);
#endif
    GSYNC();
#if (PHMASK >> 9) & 1
    phase_norm(p, 1, 0, false, (bf16_t*)(p.ws + O_H), false, 11, 0, 5);
#endif
    GSYNC();
#if (PHMASK >> 10) & 1
    phase_inproj1(p, shm);
#endif
    GSYNC();
#if (PHMASK >> 11) & 1
    for (int it = blockIdx.x; it < 256; it += gridDim.x) {
        const int xcd = it & 7, slot = it >> 3, g = (slot >> 2) * 8 + xcd, vs = slot & 3;
        scan_item(p, shm, gridDim.x == 256 ? g * 4 + vs : it);
    }
#endif
    GSYNC();
#if (PHMASK >> 12) & 1
    phase_gn(p, shm);
#endif
    GSYNC();
#if (PHMASK >> 13) & 1
    phase_gemm_resid(p, shm, p.ws + O_OF, p.ws + O_WOUT1, 4096, 1, 2, false, true, true);
#endif
    GSYNC();
#if (PHMASK >> 14) & 1
    phase_norm(p, 1, 1, false, (bf16_t*)(p.ws + O_H1), true, 0, 0, 0);
#endif
    GSYNC();
#if (PHMASK >> 15) & 1
    phase_ffn1(p, shm, p.ws + O_H1, p.ws + O_WGU1, (bf16_t*)(p.ws + O_HID1), true);
#endif
    GSYNC();
#if (PHMASK >> 16) & 1
    phase_gemm_resid(p, shm, p.ws + O_HID1, p.ws + O_WDN1, FF, 1, 5, false, true, false);
#endif
    GSYNC();
#if (PHMASK >> 17) & 1
    phase_final(p);
#endif
}

extern "C" void kernel_launch(void* const* d_in, const int* in_sizes, int n_in, void* d_out, int out_size, void* d_ws, size_t ws_size,
                              hipStream_t stream) {
    constexpr size_t kDynLds = 2 * 53248 + 2 * 16384 + 1024;
    static int grid_blocks = 0;
    if (!grid_blocks) {
        int dev = 0, cus = 0, per_cu = 0;
        hipGetDevice(&dev);
        hipDeviceGetAttribute(&cus, hipDeviceAttributeMultiprocessorCount, dev);
        hipFuncSetAttribute((const void*)fwd_megakernel, hipFuncAttributeMaxDynamicSharedMemorySize, (int)kDynLds);
        hipOccupancyMaxActiveBlocksPerMultiprocessor(&per_cu, fwd_megakernel, NTHR, kDynLds);
        if (per_cu < 1) per_cu = 1;
        if (per_cu > 1) per_cu = 1;
        grid_blocks = cus * per_cu;
    }
    if (ws_size < WS_NEED) { fprintf(stderr, "workspace too small: %zu < %zu\n", ws_size, WS_NEED); return; }
    P p{};
    const float* const* in = (const float* const*)d_in;
    p.x = in[0]; p.c = in[1]; p.ctx = in[2]; p.c_ctx = in[3]; p.mod_w = in[4]; p.mod_b = in[5]; p.norm_mix_g = in[6]; p.norm_ffn_g = in[7];
    p.w_gate = in[8]; p.w_up = in[9]; p.w_down = in[10]; p.ab_w_in = in[11]; p.ab_w_out = in[12]; p.sink = in[13]; p.q_norm_g = in[14];
    p.w_q_b = in[15]; p.kv_norm_g = in[16]; p.w_kv_b = in[17]; p.ret_w_in = in[18]; p.lf = in[19]; p.lb = in[20]; p.gn_g = in[21];
    p.ret_w_out = in[22]; p.final_g = in[23];
    p.out = (float*)d_out;
    p.ws = (char*)d_ws;
    (void)hipMemsetAsync((char*)d_ws + O_BAR, 0, XCD_BAR_WORDS * sizeof(unsigned), stream);
    void* args[] = {&p};
    hipError_t e = hipLaunchCooperativeKernel((const void*)fwd_megakernel, dim3(grid_blocks), dim3(NTHR), args, kDynLds, stream);
    if (e != hipSuccess) fprintf(stderr, "cooperative launch failed: %s (grid %d)\n", hipGetErrorString(e), grid_blocks);
}
```

```cpp
#include <hip/hip_runtime.h>
#include <hip/hip_cooperative_groups.h>
#include <cstdio>
namespace cg = cooperative_groups;

typedef unsigned short bf16_t;
typedef short bf16x8 __attribute__((ext_vector_type(8)));
typedef short s16x4 __attribute__((ext_vector_type(4)));
typedef float f32x4 __attribute__((ext_vector_type(4)));
typedef float f32x2 __attribute__((ext_vector_type(2)));
typedef float f32x16 __attribute__((ext_vector_type(16)));
typedef __bf16 bf16v2 __attribute__((ext_vector_type(2)));
typedef unsigned u32x2 __attribute__((ext_vector_type(2)));
typedef unsigned u32x4 __attribute__((ext_vector_type(4)));
#define DI __device__ __forceinline__

constexpr int DM = 2048, NBATCH = 4, SEQ = 4096, CTXL = 256, PB = 4352, NROW = 17408, FF = 5632;
constexpr int NTHR = 512;
constexpr size_t MB = 1u << 20;
constexpr float LOG2E = 1.4426950408889634f;

constexpr size_t O_MOD = 0, O_COSA = 1 * MB, O_SINA = 2 * MB, O_COSB = 3 * MB, O_SINB = 3 * MB + MB / 2, O_COSR = 4 * MB, O_SINR = 6 * MB,
                 O_BAR = 8 * MB, O_XCTX = 9 * MB;
constexpr size_t O_WIN0 = 17 * MB, O_WQB = 27 * MB, O_WKVB = 29 * MB, O_WOUT0 = 30 * MB, O_WGU0 = 38 * MB, O_WDN0 = 82 * MB, O_WIN1 = 104 * MB;
constexpr size_t O_H = 152 * MB;
constexpr size_t O_QA = 220 * MB, O_KA = 254 * MB, O_VAT = 263 * MB, O_QLAT = 272 * MB, O_KVLAT = 289 * MB, O_KR = 298 * MB, O_QM = 301 * MB,
                 O_KN = 352 * MB, O_VMT = 386 * MB, O_OCAT = 420 * MB, O_HID0 = 220 * MB;
constexpr size_t O_K1 = 17 * MB, O_Q1 = 220 * MB, O_V1T = 284 * MB, O_G1 = 420 * MB, O_OF = 548 * MB, O_OB = 88 * MB;
constexpr size_t O_WGU1 = 17 * MB, O_WDN1 = 61 * MB, O_WOUT1 = 220 * MB, O_H1 = 284 * MB, O_HID1 = 352 * MB;
constexpr size_t O_PART = 488 * MB;
constexpr size_t WS_NEED = 676 * MB;

struct P {
    const float *x, *c, *ctx, *c_ctx, *mod_w, *mod_b, *norm_mix_g, *norm_ffn_g, *w_gate, *w_up, *w_down, *ab_w_in, *ab_w_out, *sink, *q_norm_g,
        *w_q_b, *kv_norm_g, *w_kv_b, *ret_w_in, *lf, *lb, *gn_g, *ret_w_out, *final_g;
    float* out;
    char* ws;
};

DI unsigned pk2(float lo, float hi) {
    f32x2 v = {lo, hi};
    bf16v2 r = __builtin_convertvector(v, bf16v2);
    return __builtin_bit_cast(unsigned, r);
}
DI float bf2f(unsigned short b) { return __uint_as_float(((unsigned)b) << 16); }
DI bf16x8 pack8(float a0, float a1, float a2, float a3, float a4, float a5, float a6, float a7) {
    u32x4 p = {pk2(a0, a1), pk2(a2, a3), pk2(a4, a5), pk2(a6, a7)};
    return __builtin_bit_cast(bf16x8, p);
}
DI void st4(bf16_t* dst, float a, float b, float c, float d) {
    u32x2 v = {pk2(a, b), pk2(c, d)};
    *(u32x2*)dst = v;
}
DI float wsum(float v) {
#pragma unroll
    for (int o = 32; o > 0; o >>= 1) v += __shfl_xor(v, o);
    return v;
}
DI int tidx() { int t = threadIdx.x; asm volatile("" : "+v"(t)); return t; }
DI float silu_f(float g) { return g * __builtin_amdgcn_rcpf(1.f + __builtin_amdgcn_exp2f(-LOG2E * g)); }
DI int crow(int r, int h) { return (r & 3) + 8 * (r >> 2) + 4 * h; }
#define MFMA32(a, b, c) __builtin_amdgcn_mfma_f32_32x32x16_bf16((a), (b), (c), 0, 0, 0)

DI float* xrow(const P& p, int r) {
    const int b = r / PB, q = r - b * PB;
    return q < CTXL ? (float*)(p.ws + O_XCTX) + (size_t)(b * CTXL + q) * DM : p.out + (size_t)(b * SEQ + q - CTXL) * DM;
}
DI const float* inrow(const P& p, int r) {
    const int b = r / PB, q = r - b * PB;
    return q < CTXL ? p.ctx + (size_t)(b * CTXL + q) * DM : p.x + (size_t)(b * SEQ + q - CTXL) * DM;
}
DI const float* modv(const P& p, int l, int r, int ch) {
    const int b = r / PB, q = r - b * PB;
    const int bb = q < CTXL ? 4 : b;
    return (const float*)(p.ws + O_MOD) + ((size_t)(l * 5 + bb) * 6 + ch) * DM;
}

constexpr int BM = 256, BK = 64, HALF = 128, HT = HALF * BK;
typedef f32x4 Acc[2][2][4][2];
DI int lds_byte(int r, int c) {
    int st = (r >> 4) * 2 + (c >> 5), rr = r & 15, cc = c & 31, ob = rr * 64 + cc * 2;
    return st * 1024 + (ob ^ (((ob >> 9) & 1) << 5));
}
DI void stage_rc(int b, int& R, int& C) {
    int st = b / 1024, sb = b % 1024, swz = sb ^ (((sb >> 9) & 1) << 5);
    R = (st >> 1) * 16 + swz / 64;
    C = (st & 1) * 32 + (swz % 64) / 2;
}
#define LAS __attribute__((address_space(3)))
constexpr int HTB = HALF * BK * 2;
DI void gemm_tile(const bf16_t* __restrict__ A, const bf16_t* __restrict__ Bt, const int K, const int brow, const int bcol, LAS unsigned char* lds, Acc& acc) {
    const int tid = tidx(), wid = __builtin_amdgcn_readfirstlane(tid >> 6), lane = tid & 63, wr = wid >> 2, wc = wid & 3, fr = lane & 15, fq = lane >> 4;
    const int nt = K / BK;
    unsigned voff[2];
#pragma unroll
    for (int i = 0; i < 2; ++i) { int R, C; stage_rc(tid * 16 + i * 8192, R, C); voff[i] = (unsigned)(R * K + C) * 2u; }
    const size_t kstep = (size_t)(BK * 2), hstep = (size_t)HALF * K * 2;
    const unsigned ldsw = (unsigned)wid * 1024u;
    const int aoff = lds_byte(wr * 64 + fr, fq * 8), boff = lds_byte(wc * 32 + fr, fq * 8);
    const char* cA = (const char*)A + (size_t)brow * K * 2;
    const char* cB = (const char*)Bt + (size_t)bcol * K * 2;
#define SAo(b, h) (((b) * 2 + (h)) * HTB)
#define SBo(b, h) ((4 + (b) * 2 + (h)) * HTB)
#define STAGE(bufoff, gbase)                                                                                                       \
    do {                                                                                                                           \
        _Pragma("unroll") for (int _i = 0; _i < 2; ++_i)                                                                           \
            __builtin_amdgcn_global_load_lds((const unsigned*)((const char*)(gbase) + voff[_i]), (LAS unsigned*)(lds + (bufoff) + ldsw + _i * 8192), 16, 0, 0); \
    } while (0)
#define LDA(dst, b, h)                                                                                                             \
    do {                                                                                                                           \
        _Pragma("unroll") for (int m = 0; m < 4; ++m) _Pragma("unroll") for (int k = 0; k < 2; ++k)                                \
            dst[m][k] = *(const LAS bf16x8*)(lds + SAo(b, h) + aoff + m * 2048 + k * 1024);                                        \
    } while (0)
#define LDB(dst, b, h)                                                                                                             \
    do {                                                                                                                           \
        _Pragma("unroll") for (int n = 0; n < 2; ++n) _Pragma("unroll") for (int k = 0; k < 2; ++k)                                \
            dst[n][k] = *(const LAS bf16x8*)(lds + SBo(b, h) + boff + n * 2048 + k * 1024);                                        \
    } while (0)
#define MMA(ai, bj, At, Bx)                                                                                                        \
    do {                                                                                                                           \
        __builtin_amdgcn_s_setprio(1);                                                                                             \
        _Pragma("unroll") for (int m = 0; m < 4; ++m) _Pragma("unroll") for (int n = 0; n < 2; ++n) _Pragma("unroll") for (int k = 0; k < 2; ++k) \
            acc[ai][bj][m][n] = __builtin_amdgcn_mfma_f32_16x16x32_bf16(Bx[n][k], At[m][k], acc[ai][bj][m][n], 0, 0, 0);           \
        __builtin_amdgcn_s_setprio(0);                                                                                             \
    } while (0)
#define WAIT_V(n) asm volatile("s_waitcnt vmcnt(" #n ")" ::: "memory")
#define WAIT_L(n) asm volatile("s_waitcnt lgkmcnt(" #n ")" ::: "memory")
#define BAR __builtin_amdgcn_s_barrier()
#define SCHED __builtin_amdgcn_sched_barrier(0)
#pragma unroll
    for (int a = 0; a < 2; ++a)
#pragma unroll
        for (int b = 0; b < 2; ++b)
#pragma unroll
            for (int m = 0; m < 4; ++m)
#pragma unroll
                for (int n = 0; n < 2; ++n) acc[a][b][m][n] = (f32x4){0.f, 0.f, 0.f, 0.f};
    bf16x8 At[4][2], B0[2][2], B1[2][2];
    STAGE(SBo(0, 0), cB); STAGE(SAo(0, 0), cA); STAGE(SBo(0, 1), cB + hstep); STAGE(SAo(0, 1), cA + hstep);
    if (wr == 1) BAR;
    WAIT_V(4); BAR;
    STAGE(SBo(1, 0), cB + kstep); STAGE(SAo(1, 0), cA + kstep); STAGE(SBo(1, 1), cB + hstep + kstep);
    WAIT_V(6); BAR;
    for (int t = 0; t < nt - 2; t += 2) {
        const char* a1 = cA + (size_t)(t + 1) * kstep;
        const char* a2 = cA + (size_t)(t + 2) * kstep; const char* b2 = cB + (size_t)(t + 2) * kstep;
        const char* a3 = a2 + kstep; const char* b3 = b2 + kstep;
        LDB(B0, 0, 0); SCHED; LDA(At, 0, 0); STAGE(SAo(1, 1), a1 + hstep);
        WAIT_L(8); BAR; WAIT_L(0); MMA(0, 0, At, B0); BAR; SCHED;
        LDB(B1, 0, 1); STAGE(SBo(0, 0), b2);
        BAR; WAIT_L(0); MMA(0, 1, At, B1); BAR;
        LDA(At, 0, 1); STAGE(SAo(0, 0), a2);
        BAR; WAIT_L(0); MMA(1, 0, At, B0); BAR; SCHED;
        STAGE(SBo(0, 1), b2 + hstep);
        WAIT_V(6); BAR; MMA(1, 1, At, B1); BAR;
        LDB(B0, 1, 0); SCHED; LDA(At, 1, 0); STAGE(SAo(0, 1), a2 + hstep);
        WAIT_L(8); BAR; WAIT_L(0); MMA(0, 0, At, B0); BAR; SCHED;
        LDB(B1, 1, 1); STAGE(SBo(1, 0), b3);
        BAR; WAIT_L(0); MMA(0, 1, At, B1); BAR;
        LDA(At, 1, 1); STAGE(SAo(1, 0), a3);
        BAR; WAIT_L(0); MMA(1, 0, At, B0); BAR; SCHED;
        STAGE(SBo(1, 1), b3 + hstep);
        WAIT_V(6); BAR; MMA(1, 1, At, B1); BAR;
    }
    { LDB(B0, 0, 0); LDA(At, 0, 0); STAGE(SAo(1, 1), cA + (size_t)(nt - 1) * kstep + hstep);
      BAR; WAIT_L(0); MMA(0, 0, At, B0); BAR;
      LDB(B1, 0, 1); BAR; WAIT_L(0); MMA(0, 1, At, B1); BAR;
      LDA(At, 0, 1); WAIT_V(4); BAR; WAIT_L(0); MMA(1, 0, At, B0); MMA(1, 1, At, B1); BAR; }
    { LDB(B0, 1, 0); LDA(At, 1, 0); WAIT_V(2); BAR; WAIT_L(0); MMA(0, 0, At, B0); BAR;
      LDB(B1, 1, 1); WAIT_V(0); BAR; WAIT_L(0); MMA(0, 1, At, B1); BAR;
      LDA(At, 1, 1); BAR; WAIT_L(0); MMA(1, 0, At, B0); MMA(1, 1, At, B1); BAR; }
    if (wr == 0) BAR;
#undef SAo
#undef SBo
#undef STAGE
#undef LDA
#undef LDB
#undef MMA
}
struct Unit { const char* A; const char* B; int pm, pn; };
template <class Get, class Epi>
DI void gemm_stream(LAS unsigned char* lds, const int K, const int ld, Get get, Epi epi) {
    const int tid = tidx(), wid = __builtin_amdgcn_readfirstlane(tid >> 6), lane = tid & 63, wr = wid >> 2, wc = wid & 3, fr = lane & 15, fq = lane >> 4;
    const int nt = K / BK;
    unsigned voff[2];
#pragma unroll
    for (int i = 0; i < 2; ++i) { int R, C; stage_rc(tid * 16 + i * 8192, R, C); voff[i] = (unsigned)(R * ld + C) * 2u; }
    const size_t kstep = (size_t)(BK * 2), hstep = (size_t)HALF * ld * 2;
    const unsigned ldsw = (unsigned)wid * 1024u;
    const int aoff = lds_byte(wr * 64 + fr, fq * 8), boff = lds_byte(wc * 32 + fr, fq * 8);
#define SAo(b, h) (((b) * 2 + (h)) * HTB)
#define SBo(b, h) ((4 + (b) * 2 + (h)) * HTB)
#define STAGE(bufoff, gbase)                                                                                                       \
    do {                                                                                                                           \
        _Pragma("unroll") for (int _i = 0; _i < 2; ++_i)                                                                           \
            __builtin_amdgcn_global_load_lds((const unsigned*)((const char*)(gbase) + voff[_i]), (LAS unsigned*)(lds + (bufoff) + ldsw + _i * 8192), 16, 0, 0); \
    } while (0)
#define LDA(dst, b, h)                                                                                                             \
    do {                                                                                                                           \
        _Pragma("unroll") for (int m = 0; m < 4; ++m) _Pragma("unroll") for (int k = 0; k < 2; ++k)                                \
            dst[m][k] = *(const LAS bf16x8*)(lds + SAo(b, h) + aoff + m * 2048 + k * 1024);                                        \
    } while (0)
#define LDB(dst, b, h)                                                                                                             \
    do {                                                                                                                           \
        _Pragma("unroll") for (int n = 0; n < 2; ++n) _Pragma("unroll") for (int k = 0; k < 2; ++k)                                \
            dst[n][k] = *(const LAS bf16x8*)(lds + SBo(b, h) + boff + n * 2048 + k * 1024);                                        \
    } while (0)
#define MMA(ai, bj, At, Bx)                                                                                                        \
    do {                                                                                                                           \
        __builtin_amdgcn_s_setprio(1);                                                                                             \
        _Pragma("unroll") for (int m = 0; m < 4; ++m) _Pragma("unroll") for (int n = 0; n < 2; ++n) _Pragma("unroll") for (int k = 0; k < 2; ++k) \
            acc[ai][bj][m][n] = __builtin_amdgcn_mfma_f32_16x16x32_bf16(Bx[n][k], At[m][k], acc[ai][bj][m][n], 0, 0, 0);           \
        __builtin_amdgcn_s_setprio(0);                                                                                             \
    } while (0)
#define ZERO_ACC                                                                                                                   \
    _Pragma("unroll") for (int a = 0; a < 2; ++a) _Pragma("unroll") for (int b = 0; b < 2; ++b) _Pragma("unroll") for (int m = 0; m < 4; ++m) \
        _Pragma("unroll") for (int n = 0; n < 2; ++n) acc[a][b][m][n] = (f32x4){0.f, 0.f, 0.f, 0.f}
    Unit cur, nxt;
    int ui = 0;
    if (!get(0, cur)) return;
    Acc acc;
    ZERO_ACC;
    bf16x8 At[4][2], B0[2][2], B1[2][2];
    const char* cA = cur.A;
    const char* cB = cur.B;
    STAGE(SBo(0, 0), cB); STAGE(SAo(0, 0), cA); STAGE(SBo(0, 1), cB + hstep); STAGE(SAo(0, 1), cA + hstep);
    if (wr == 1) BAR;
    WAIT_V(4); BAR;
    STAGE(SBo(1, 0), cB + kstep); STAGE(SAo(1, 0), cA + kstep); STAGE(SBo(1, 1), cB + hstep + kstep);
    WAIT_V(6); BAR;
    for (;;) {
        const bool has_next = get(ui + 1, nxt);
        const char* nA = has_next ? nxt.A : cA;
        const char* nB = has_next ? nxt.B : cB;
        for (int t = 0; t < nt; t += 2) {
            const bool last = (t == nt - 2);
            const char* a1 = cA + (size_t)(t + 1) * kstep;
            const char* a2 = last ? nA : cA + (size_t)(t + 2) * kstep;
            const char* b2 = last ? nB : cB + (size_t)(t + 2) * kstep;
            const char* a3 = a2 + kstep;
            const char* b3 = b2 + kstep;
            LDB(B0, 0, 0); SCHED; LDA(At, 0, 0); STAGE(SAo(1, 1), a1 + hstep);
            WAIT_L(8); BAR; WAIT_L(0); MMA(0, 0, At, B0); BAR; SCHED;
            LDB(B1, 0, 1); STAGE(SBo(0, 0), b2);
            BAR; WAIT_L(0); MMA(0, 1, At, B1); BAR;
            LDA(At, 0, 1); STAGE(SAo(0, 0), a2);
            BAR; WAIT_L(0); MMA(1, 0, At, B0); BAR; SCHED;
            STAGE(SBo(0, 1), b2 + hstep);
            WAIT_V(6); BAR; MMA(1, 1, At, B1); BAR;
            LDB(B0, 1, 0); SCHED; LDA(At, 1, 0); STAGE(SAo(0, 1), a2 + hstep);
            WAIT_L(8); BAR; WAIT_L(0); MMA(0, 0, At, B0); BAR; SCHED;
            LDB(B1, 1, 1); STAGE(SBo(1, 0), b3);
            BAR; WAIT_L(0); MMA(0, 1, At, B1); BAR;
            LDA(At, 1, 1); STAGE(SAo(1, 0), a3);
            BAR; WAIT_L(0); MMA(1, 0, At, B0); BAR; SCHED;
            STAGE(SBo(1, 1), b3 + hstep);
            WAIT_V(6); BAR; MMA(1, 1, At, B1); BAR;
        }
        epi(acc, cur);
        if (!has_next) break;
        ZERO_ACC;
        cur = nxt; cA = nA; cB = nB; ++ui;
    }
    WAIT_V(0);
    if (wr == 0) BAR;
    BAR;
#undef SAo
#undef SBo
#undef STAGE
#undef LDA
#undef LDB
#undef MMA
#undef ZERO_ACC
}
#define EPI_IDX int tidx_ = threadIdx.x; asm volatile("" : "+v"(tidx_)); const int wid = tidx_ >> 6, lane = tidx_ & 63, wr = wid >> 2, wc = wid & 3, fr = lane & 15, fq = lane >> 4; (void)wc; (void)fq; (void)fr; (void)wr;
#define EPI_DONE do { } while (0)

DI void tile_of(int L, int nM, int nN, int& pm, int& pn) {
    const int nwg = nM * nN;
    int wgid = L;
    { const int q = nwg / 8, r = nwg % 8, xcd = wgid % 8, off = wgid / 8; wgid = (xcd < r ? xcd * (q + 1) : r * (q + 1) + (xcd - r) * q) + off; }
    constexpr int WGM = 4;
    const int nig = WGM * nN, gid = wgid / nig, fm = gid * WGM, gsz = (nM - fm) < WGM ? (nM - fm) : WGM;
    pm = fm + ((wgid % nig) % gsz);
    pn = (wgid % nig) / gsz;
}

DI void epi_plain(const Acc& acc, int brow, bf16_t* dst, int ld, int coff, const float* rs) {
    EPI_IDX
#pragma unroll
    for (int ai = 0; ai < 2; ++ai)
#pragma unroll
        for (int m = 0; m < 4; ++m) {
            const int lr = ai * 128 + wr * 64 + m * 16 + fr;
            const float s = rs ? rs[lr] : 1.f;
            bf16_t* rp = dst + (size_t)(brow + lr) * ld + coff + wc * 32 + fq * 4;
#pragma unroll
            for (int bj = 0; bj < 2; ++bj)
#pragma unroll
                for (int n = 0; n < 2; ++n) { const f32x4 v = acc[ai][bj][m][n]; st4(rp + bj * 128 + n * 16, v[0] * s, v[1] * s, v[2] * s, v[3] * s); }
        }
    EPI_DONE;
}
template <int R>
DI void epi_rope(const Acc& acc, const P& p, int brow, bf16_t* __restrict__ dst, int ld, int coff, int bstride, const float* rs, int nblk_valid) {
    EPI_IDX
    const float* __restrict__ cosT = (const float*)(p.ws + (R == 128 ? O_COSA : O_COSB));
    const float* __restrict__ sinT = (const float*)(p.ws + (R == 128 ? O_SINA : O_SINB));
    const int b = brow / PB, p0 = brow - b * PB;
    const bool ctx = p0 < CTXL;
#pragma unroll
    for (int ai = 0; ai < 2; ++ai)
#pragma unroll
        for (int m = 0; m < 4; ++m) {
            const int lr = ai * 128 + wr * 64 + m * 16 + fr;
            const float s = rs ? rs[lr] : 1.f;
            const int sq = p0 + lr - CTXL;
#pragma unroll
            for (int bj = 0; bj < 2; ++bj) {
                const int blk = R == 128 ? bj : bj * 2 + (wc >> 1);
                const int d0 = (R == 128 ? wc * 16 : (wc & 1) * 16) + fq * 4;
                if (blk < nblk_valid) {
                    f32x4 cv = {1.f, 1.f, 1.f, 1.f}, sv = {0.f, 0.f, 0.f, 0.f};
                    if (!ctx) { cv = *(const f32x4*)(cosT + (size_t)sq * (R / 2) + d0); sv = *(const f32x4*)(sinT + (size_t)sq * (R / 2) + d0); }
                    const f32x4 x1 = acc[ai][bj][m][0] * s, x2 = acc[ai][bj][m][1] * s;
                    const f32x4 o1 = x1 * cv - x2 * sv, o2 = x1 * sv + x2 * cv;
                    bf16_t* rp = dst + (size_t)(brow + lr) * ld + coff + blk * bstride + d0;
                    st4(rp, o1[0], o1[1], o1[2], o1[3]);
                    st4(rp + R / 2, o2[0], o2[1], o2[2], o2[3]);
                }
                __builtin_amdgcn_sched_barrier(0);
            }
        }
    EPI_DONE;
}
DI void epi_rope256(const Acc& acc, const P& p, int brow, bf16_t* __restrict__ dst, size_t dstrow0, int coff, float scale) {
    EPI_IDX
    const float* __restrict__ cosT = (const float*)(p.ws + O_COSR);
    const float* __restrict__ sinT = (const float*)(p.ws + O_SINR);
    const int b = brow / PB, p0 = brow - b * PB;
    const bool ctx = p0 < CTXL;
#pragma unroll
    for (int ai = 0; ai < 2; ++ai)
#pragma unroll
        for (int m = 0; m < 4; ++m) {
            const int lr = ai * 128 + wr * 64 + m * 16 + fr;
            const int sq = p0 + lr - CTXL;
#pragma unroll
            for (int n = 0; n < 2; ++n) {
                const int d0 = wc * 32 + n * 16 + fq * 4;
                f32x4 cv = {1.f, 1.f, 1.f, 1.f}, sv = {0.f, 0.f, 0.f, 0.f};
                if (!ctx) { cv = *(const f32x4*)(cosT + (size_t)sq * 128 + d0); sv = *(const f32x4*)(sinT + (size_t)sq * 128 + d0); }
                const f32x4 x1 = acc[ai][0][m][n] * scale, x2 = acc[ai][1][m][n] * scale;
                const f32x4 o1 = x1 * cv - x2 * sv, o2 = x1 * sv + x2 * cv;
                bf16_t* rp = dst + (dstrow0 + lr) * (size_t)DM + coff + d0;
                st4(rp, o1[0], o1[1], o1[2], o1[3]);
                st4(rp + 128, o2[0], o2[1], o2[2], o2[3]);
            }
        }
    EPI_DONE;
}
template <int CH>
DI void epi_T(const Acc& acc, int f0, int tok0, bf16_t* dst, int NF, const float* rs) {
    EPI_IDX
    const int b = tok0 / PB, p0 = tok0 - b * PB;
#pragma unroll
    for (int ai = 0; ai < 2; ++ai)
#pragma unroll
        for (int m = 0; m < 4; ++m) {
            const int feat = f0 + ai * 128 + wr * 64 + m * 16 + fr;
#pragma unroll
            for (int bj = 0; bj < 2; ++bj)
#pragma unroll
                for (int n = 0; n < 2; ++n) {
                    const int lc = bj * 128 + wc * 32 + n * 16 + fq * 4;
                    f32x4 v = acc[ai][bj][m][n];
                    if (rs) { v[0] *= rs[lc]; v[1] *= rs[lc + 1]; v[2] *= rs[lc + 2]; v[3] *= rs[lc + 3]; }
                    const int pp = p0 + lc;
                    st4(dst + (((size_t)b * (PB / CH) + pp / CH) * NF + feat) * CH + pp % CH, v[0], v[1], v[2], v[3]);
                }
        }
    EPI_DONE;
}
DI void epi_resid(const Acc& acc, const P& p, int brow, int bcol, int layer, int gch, bool from_input) {
    EPI_IDX
    const float* gate = modv(p, layer, brow, gch);
#pragma unroll
    for (int bj = 0; bj < 2; ++bj)
#pragma unroll
        for (int n = 0; n < 2; ++n) {
            const int c0 = bcol + bj * 128 + wc * 32 + n * 16 + fq * 4;
            const f32x4 g = *(const f32x4*)(gate + c0);
            f32x4 xv[2][4];
#pragma unroll
            for (int ai = 0; ai < 2; ++ai)
#pragma unroll
                for (int m = 0; m < 4; ++m) {
                    const int r = brow + ai * 128 + wr * 64 + m * 16 + fr;
                    const float* sp = (from_input ? inrow(p, r) : xrow(p, r)) + c0;
                    xv[ai][m] = *(const f32x4*)sp;
                }
            __builtin_amdgcn_sched_barrier(0);
#pragma unroll
            for (int ai = 0; ai < 2; ++ai)
#pragma unroll
                for (int m = 0; m < 4; ++m) {
                    const int r = brow + ai * 128 + wr * 64 + m * 16 + fr;
                    *(f32x4*)(xrow(p, r) + c0) = xv[ai][m] + g * acc[ai][bj][m][n];
                }
            __builtin_amdgcn_sched_barrier(0);
        }
    EPI_DONE;
}
DI void epi_part(const Acc& acc, const P& p, int brow, int bcol, int sl) {
    EPI_IDX
    const int b = brow / PB;
    float* part = (float*)(p.ws + O_PART) + ((size_t)sl * (NBATCH * CTXL) + b * CTXL) * DM;
#pragma unroll
    for (int ai = 0; ai < 2; ++ai)
#pragma unroll
        for (int m = 0; m < 4; ++m) {
            float* rp = part + (size_t)(ai * 128 + wr * 64 + m * 16 + fr) * DM + bcol + wc * 32 + fq * 4;
#pragma unroll
            for (int bj = 0; bj < 2; ++bj)
#pragma unroll
                for (int n = 0; n < 2; ++n) *(f32x4*)(rp + bj * 128 + n * 16) = acc[ai][bj][m][n];
        }
    EPI_DONE;
}
DI void epi_swiglu(const Acc& acc, int brow, int pn, bf16_t* hid) {
    EPI_IDX
#pragma unroll
    for (int ai = 0; ai < 2; ++ai)
#pragma unroll
        for (int m = 0; m < 4; ++m) {
            const int r = brow + ai * 128 + wr * 64 + m * 16 + fr;
            bf16_t* rp = hid + (size_t)r * FF + pn * 128 + wc * 32 + fq * 4;
#pragma unroll
            for (int n = 0; n < 2; ++n) {
                const f32x4 g = acc[ai][0][m][n], u = acc[ai][1][m][n];
                float o[4];
#pragma unroll
                for (int j = 0; j < 4; ++j) o[j] = silu_f(g[j]) * u[j];
                st4(rp + n * 16, o[0], o[1], o[2], o[3]);
            }
        }
    EPI_DONE;
}

DI int perm128(int q) { return 64 * ((q >> 4) & 1) + 16 * (q >> 5) + (q & 15); }
DI int perm64(int q) { return 32 * ((q >> 4) & 1) + 16 * (q >> 5) + (q & 15); }
enum { CK_NAT = 0, CK_IN0, CK_QB, CK_KVB, CK_GU };
DI int srccol(int kind, int pos, int& which) {
    which = 0;
    switch (kind) {
        case CK_IN0: {
            if (pos < 1280) { const int blk = pos >> 7; return blk * 128 + perm128(pos & 127); }
            if (pos < 2304) return pos;
            const int q = pos - 2304;
            return q < 64 ? 2304 + perm64(q) : -1;
        }
        case CK_QB: {
            if (pos < 1024) return (pos >> 7) * 192 + (pos & 127);
            const int qq = pos - 1024;
            return (qq >> 6) * 192 + 128 + perm64(qq & 63);
        }
        case CK_KVB: {
            if (pos < 1024) return (pos >> 7) * 256 + (pos & 127);
            const int qq = pos - 1024;
            return (qq >> 7) * 256 + 128 + (qq & 127);
        }
        case CK_GU: {
            const int t = pos >> 8, q = pos & 255;
            which = q >> 7;
            return t * 128 + (q & 127);
        }
        default: return pos;
    }
}
DI void conv_tile(const float* s1, const float* s2, const float* kscale, bf16_t* dst, int K, int Nsrc, int Ndst, int kind, int tile, float* lt  ) {
    const int tid = tidx();
    const int nnt = Ndst / 256;
    const int n0 = (tile % nnt) * 256, k0 = (tile / nnt) * 64;
    {
        const int nn = tid & 255, kk0 = tid >> 8;
        int which;
        const int sc = srccol(kind, n0 + nn, which);
        const float* s = (which ? s2 : s1) + (size_t)k0 * Nsrc + (sc >= 0 ? sc : 0);
        float v[32], ksv[32];
#pragma unroll
        for (int i = 0; i < 32; ++i) v[i] = sc >= 0 ? s[(size_t)(kk0 + 2 * i) * Nsrc] : 0.f;
#pragma unroll
        for (int i = 0; i < 32; ++i) ksv[i] = kscale ? kscale[k0 + kk0 + 2 * i] : 1.f;
#pragma unroll
        for (int i = 0; i < 32; ++i) {
            const int kk = kk0 + 2 * i;
            lt[kk * 257 + nn] = v[i] * ksv[i];
        }
    }
    __syncthreads();
#pragma unroll
    for (int i = 0; i < 4; ++i) {
        const int c = tid + NTHR * i, n = c >> 3, kc = c & 7;
        float v[8];
#pragma unroll
        for (int e = 0; e < 8; ++e) v[e] = lt[(kc * 8 + e) * 257 + n];
        *(bf16x8*)(dst + (size_t)(n0 + n) * K + k0 + kc * 8) = pack8(v[0], v[1], v[2], v[3], v[4], v[5], v[6], v[7]);
    }
    __syncthreads();
}
DI void conv_job(const float* s1, const float* s2, const float* ks, bf16_t* dst, int K, int Nsrc, int Ndst, int kind, int& base, char* shm) {
    const int nt = (Ndst / 256) * (K / 64);
    const int first = ((int)blockIdx.x - (base % (int)gridDim.x) + (int)gridDim.x) % (int)gridDim.x;
    for (int t = first; t < nt; t += gridDim.x) conv_tile(s1, s2, ks, dst, K, Nsrc, Ndst, kind, t, (float*)shm);
    base += nt;
}

DI void phase0(const P& p, char* shm) {
    const int tid = tidx();
    {
        float* sc = (float*)shm;
        float* part = (float*)(shm + 5 * DM * 4);
        for (int i = tid; i < 5 * DM; i += NTHR) {
            const int r = i / DM, k = i - r * DM;
            const float v = r < 4 ? p.c[r * DM + k] : p.c_ctx[k];
            sc[i] = v / (1.f + __expf(-v));
        }
        __syncthreads();
        for (int item = blockIdx.x; item < 384; item += gridDim.x) {
            const int cl = tid & 63, ks = tid >> 6;
            const int gc = item * 64 + cl, layer = gc / 12288, col = gc - layer * 12288;
            const float* w = p.mod_w + ((size_t)layer * DM + ks * 256) * 12288 + col;
            float a0 = 0.f, a1 = 0.f, a2 = 0.f, a3 = 0.f, a4 = 0.f;
#pragma unroll 16
            for (int k = 0; k < 256; ++k) {
                const float wv = w[(size_t)k * 12288];
                const int kk = ks * 256 + k;
                a0 += sc[kk] * wv; a1 += sc[DM + kk] * wv; a2 += sc[2 * DM + kk] * wv; a3 += sc[3 * DM + kk] * wv; a4 += sc[4 * DM + kk] * wv;
            }
            float* q = part + (ks * 64 + cl) * 5;
            q[0] = a0; q[1] = a1; q[2] = a2; q[3] = a3; q[4] = a4;
            __syncthreads();
            if (tid < 320) {
                const int c2 = tid & 63, r = tid >> 6;
                const int gc2 = item * 64 + c2, layer2 = gc2 / 12288, col2 = gc2 - layer2 * 12288;
                float sum = p.mod_b[layer2 * 12288 + col2];
#pragma unroll
                for (int k8 = 0; k8 < 8; ++k8) sum += part[(k8 * 64 + c2) * 5 + r];
                ((float*)(p.ws + O_MOD))[((size_t)layer2 * 5 + r) * 12288 + col2] = sum;
            }
            __syncthreads();
        }
        __syncthreads();
    }
    {
        const int total = SEQ * 224;
        for (int i = blockIdx.x * NTHR + tid; i < total; i += gridDim.x * NTHR) {
            const int s = i / 224, e = i - s * 224;
            int nf, d; float *ct, *st;
            if (e < 64) { nf = 32; d = e; ct = (float*)(p.ws + O_COSA) + s * 64 + d; st = (float*)(p.ws + O_SINA) + s * 64 + d; }
            else if (e < 96) { nf = 16; d = e - 64; ct = (float*)(p.ws + O_COSB) + s * 32 + d; st = (float*)(p.ws + O_SINB) + s * 32 + d; }
            else { nf = 64; d = e - 96; ct = (float*)(p.ws + O_COSR) + s * 128 + d; st = (float*)(p.ws + O_SINR) + s * 128 + d; }
            const int fi = d < nf ? d : d - nf;
            const float pos = d < nf ? (float)(s >> 6) : (float)(s & 63);
            const float inv = exp2f(-(float)fi / (float)nf * 13.287712379549449f);
            const float ang = pos * inv;
            float rev = ang * 0.15915494309189535f;
            rev -= rintf(rev);
            *ct = __builtin_amdgcn_cosf(rev);
            *st = __builtin_amdgcn_sinf(rev);
        }
    }
    {
        int base = 0;
        conv_job(p.ab_w_in, nullptr, nullptr, (bf16_t*)(p.ws + O_WIN0), DM, 2368, 2560, CK_IN0, base, shm);
        conv_job(p.w_q_b, nullptr, p.q_norm_g, (bf16_t*)(p.ws + O_WQB), 512, 1536, 1536, CK_QB, base, shm);
        conv_job(p.w_kv_b, nullptr, p.kv_norm_g, (bf16_t*)(p.ws + O_WKVB), 256, 2048, 2048, CK_KVB, base, shm);
        conv_job(p.ab_w_out, nullptr, nullptr, (bf16_t*)(p.ws + O_WOUT0), DM, DM, DM, CK_NAT, base, shm);
        conv_job(p.w_gate, p.w_up, nullptr, (bf16_t*)(p.ws + O_WGU0), DM, FF, 2 * FF, CK_GU, base, shm);
        conv_job(p.w_down, nullptr, nullptr, (bf16_t*)(p.ws + O_WDN0), FF, DM, DM, CK_NAT, base, shm);
        conv_job(p.ret_w_in, nullptr, nullptr, (bf16_t*)(p.ws + O_WIN1), DM, 12288, 12288, CK_NAT, base, shm);
    }
}

DI void phase_norm(const P& p, int layer, int which, bool from_input, bf16_t* H, bool skip_ctx, int pendS, int pend_layer, int pend_gch) {
    const int tix = tidx(), lane = tix & 63, gw = blockIdx.x * (NTHR / 64) + (tix >> 6), nw = gridDim.x * (NTHR / 64);
    const float* g = (which ? p.norm_ffn_g : p.norm_mix_g) + layer * DM;
    for (int r = gw; r < NROW; r += nw) {
        const int b = r / PB, q = r - b * PB;
        if (skip_ctx && q < CTXL) continue;
        const float* src = from_input ? inrow(p, r) : xrow(p, r);
        f32x4 v[8];
        float ss = 0.f;
#pragma unroll
        for (int i = 0; i < 8; ++i) { v[i] = *(const f32x4*)(src + (i * 64 + lane) * 4); ss += v[i][0] * v[i][0] + v[i][1] * v[i][1] + v[i][2] * v[i][2] + v[i][3] * v[i][3]; }
        if (pendS > 0 && q < CTXL) {
            const float* part = (const float*)(p.ws + O_PART) + (size_t)(b * CTXL + q) * DM;
            const float* gate = modv(p, pend_layer, r, pend_gch);
            float* xr = xrow(p, r);
            ss = 0.f;
#pragma unroll
            for (int i = 0; i < 8; ++i) {
                const int c = (i * 64 + lane) * 4;
                f32x4 a = {0.f, 0.f, 0.f, 0.f};
                for (int s = 0; s < pendS; ++s) a += *(const f32x4*)(part + (size_t)s * (NBATCH * CTXL) * DM + c);
                v[i] += *(const f32x4*)(gate + c) * a;
                *(f32x4*)(xr + c) = v[i];
                ss += v[i][0] * v[i][0] + v[i][1] * v[i][1] + v[i][2] * v[i][2] + v[i][3] * v[i][3];
            }
        }
        ss = wsum(ss);
        if (from_input && q < CTXL) {
            float* xr = xrow(p, r);
#pragma unroll
            for (int i = 0; i < 8; ++i) *(f32x4*)(xr + (i * 64 + lane) * 4) = v[i];
        }
        const float rinv = rsqrtf(ss * (1.f / DM) + 1e-6f);
        const float* sh = modv(p, layer, r, which ? 3 : 0);
        const float* sc = modv(p, layer, r, which ? 4 : 1);
#pragma unroll
        for (int i = 0; i < 8; ++i) {
            const int c = (i * 64 + lane) * 4;
            const f32x4 gv = *(const f32x4*)(g + c), sv = *(const f32x4*)(sc + c), hv = *(const f32x4*)(sh + c);
            const f32x4 o = v[i] * rinv * gv * (1.f + sv) + hv;
            st4(H + (size_t)r * DM + c, o[0], o[1], o[2], o[3]);
        }
    }
}
DI void phase_final(const P& p) {
    const int tix = tidx(), lane = tix & 63, gw = blockIdx.x * (NTHR / 64) + (tix >> 6), nw = gridDim.x * (NTHR / 64);
    f32x4 gv[8];
#pragma unroll
    for (int i = 0; i < 8; ++i) gv[i] = *(const f32x4*)(p.final_g + (i * 64 + lane) * 4);
    for (int r = gw; r < NBATCH * SEQ; r += nw) {
        float* row = p.out + (size_t)r * DM;
        f32x4 v[8];
        float ss = 0.f;
#pragma unroll
        for (int i = 0; i < 8; ++i) { v[i] = *(const f32x4*)(row + (i * 64 + lane) * 4); ss += v[i][0] * v[i][0] + v[i][1] * v[i][1] + v[i][2] * v[i][2] + v[i][3] * v[i][3]; }
        ss = wsum(ss);
        const float rinv = rsqrtf(ss * (1.f / DM) + 1e-6f);
#pragma unroll
        for (int i = 0; i < 8; ++i) *(f32x4*)(row + (i * 64 + lane) * 4) = v[i] * rinv * gv[i];
    }
}

DI void phase_inproj0(const P& p, char* shm) {
    const char* H = p.ws + O_H;
    const char* W = p.ws + O_WIN0;
    const int nM = NROW / 256, nN = 10;
    auto get = [&](int i, Unit& u) {
        const long L = (long)i * gridDim.x + blockIdx.x;
        if (L >= nM * nN) return false;
        tile_of((int)L, nM, nN, u.pm, u.pn);
        const char* hp = H + (size_t)u.pm * 256 * DM * 2;
        const char* wp = W + (size_t)u.pn * 256 * DM * 2;
        const bool tr = u.pn == 5;
        u.A = tr ? wp : hp; u.B = tr ? hp : wp;
        return true;
    };
    auto epi = [&](const Acc& acc, const Unit& u) {
        const int brow = u.pm * 256, pn = u.pn;
        if (pn == 5) epi_T<64>(acc, 0, brow, (bf16_t*)(p.ws + O_VAT), 256, nullptr);
        else if (pn < 4) epi_rope<128>(acc, p, brow, (bf16_t*)(p.ws + O_QA), 1024, pn * 256, 128, nullptr, 2);
        else if (pn == 4) epi_rope<128>(acc, p, brow, (bf16_t*)(p.ws + O_KA), 256, 0, 128, nullptr, 2);
        else if (pn < 8) epi_plain(acc, brow, (bf16_t*)(p.ws + O_QLAT), 512, (pn - 6) * 256, nullptr);
        else if (pn == 8) epi_plain(acc, brow, (bf16_t*)(p.ws + O_KVLAT), 256, 0, nullptr);
        else epi_rope<64>(acc, p, brow, (bf16_t*)(p.ws + O_KR), 64, 0, 64, nullptr, 1);
    };
    gemm_stream((LAS unsigned char*)shm, DM, DM, get, epi);
}
template <int W>
DI void row_rms(const bf16_t* src, int row0, float* rs) {
    const int tid = tidx(), r = tid >> 1, hf = tid & 1;
    const bf16_t* q = src + (size_t)(row0 + r) * W + hf * (W / 2);
    float ss = 0.f;
#pragma unroll 4
    for (int i = 0; i < W / 16; ++i) {
        const bf16x8 v = *(const bf16x8*)(q + i * 8);
#pragma unroll
        for (int e = 0; e < 8; ++e) { const float f = bf2f((unsigned short)v[e]); ss += f * f; }
    }
    ss += __shfl_xor(ss, 1);
    if (hf == 0) rs[r] = rsqrtf(ss * (1.f / W) + 1e-6f);
    __syncthreads();
}
DI void phase_qkvb(const P& p, char* shm) {
    float* rs = (float*)(shm + 131072);
    Acc acc;
    const int nM = NROW / 256;
    const int total = nM * 6 + nM * 8;
    for (int L = blockIdx.x; L < total; L += gridDim.x) {
        const bool isq = L < nM * 6;
        int pm, pn;
        if (isq) tile_of(L, nM, 6, pm, pn); else tile_of(L - nM * 6, nM, 8, pm, pn);
        const int brow = pm * 256;
        if (isq) row_rms<512>((const bf16_t*)(p.ws + O_QLAT), brow, rs); else row_rms<256>((const bf16_t*)(p.ws + O_KVLAT), brow, rs);
        const bf16_t* Aact = (const bf16_t*)(p.ws + (isq ? O_QLAT : O_KVLAT));
        const bf16_t* Wt = (const bf16_t*)(p.ws + (isq ? O_WQB : O_WKVB));
        const bool tr = !isq && pn >= 4;
        gemm_tile(tr ? Wt : Aact, tr ? Aact : Wt, isq ? 512 : 256, tr ? pn * 256 : brow, tr ? brow : pn * 256, (LAS unsigned char*)shm, acc);
        if (isq) {
            if (pn < 4) {
                EPI_IDX
#pragma unroll
                for (int ai = 0; ai < 2; ++ai)
#pragma unroll
                    for (int m = 0; m < 4; ++m) {
                        const int lr = ai * 128 + wr * 64 + m * 16 + fr;
                        const float s = rs[lr];
#pragma unroll
                        for (int bj = 0; bj < 2; ++bj)
#pragma unroll
                            for (int n = 0; n < 2; ++n) {
                                const f32x4 v = acc[ai][bj][m][n];
                                st4((bf16_t*)(p.ws + O_QM) + (size_t)(brow + lr) * 1536 + (pn * 2 + bj) * 192 + wc * 32 + n * 16 + fq * 4, v[0] * s, v[1] * s, v[2] * s, v[3] * s);
                            }
                    }
                EPI_DONE;
            } else {
                epi_rope<64>(acc, p, brow, (bf16_t*)(p.ws + O_QM), 1536, (pn - 4) * 4 * 192 + 128, 192, rs, 4);
            }
        } else if (!tr) {
            epi_plain(acc, brow, (bf16_t*)(p.ws + O_KN), 1024, pn * 256, rs);
        } else {
            epi_T<64>(acc, (pn - 4) * 256, brow, (bf16_t*)(p.ws + O_VMT), 1024, rs);
        }
        __syncthreads();
    }
}
DI int brow_of(int pm, bool lat_only) { return lat_only ? (pm >> 4) * PB + CTXL + (pm & 15) * 256 : pm * 256; }
DI void phase_gemm_resid(const P& p, char* shm, const char* A, const char* W, int K, int layer, int gch, bool from_input, bool lat_only, bool a_lat) {
    const int nM = lat_only ? NBATCH * SEQ / 256 : NROW / 256, nN = DM / 256;
    auto get = [&](int i, Unit& u) {
        const long L = (long)i * gridDim.x + blockIdx.x;
        if (L >= nM * nN) return false;
        tile_of((int)L, nM, nN, u.pm, u.pn);
        const int arow = a_lat ? u.pm * 256 : brow_of(u.pm, lat_only);
        u.A = A + (size_t)arow * K * 2;
        u.B = W + (size_t)u.pn * 256 * K * 2;
        return true;
    };
    auto epi = [&](const Acc& acc, const Unit& u) { epi_resid(acc, p, brow_of(u.pm, lat_only), u.pn * 256, layer, gch, from_input); };
    gemm_stream((LAS unsigned char*)shm, K, K, get, epi);
}
DI void phase_gemm_resid_ctx(const P& p, char* shm, const char* A, const char* W, int K, int S) {
    const int nN = DM / 256, Kl = K / S, total = 4 * nN * S;
    auto get = [&](int i, Unit& u) {
        const long L = (long)i * gridDim.x + blockIdx.x;
        if (L >= total) return false;
        const int sl = (int)L % S, t = (int)L / S;
        u.pm = (t / nN) * 17; u.pn = (t % nN) + 16 * sl;
        u.A = A + ((size_t)u.pm * 256 * K + (size_t)sl * Kl) * 2;
        u.B = W + ((size_t)(t % nN) * 256 * K + (size_t)sl * Kl) * 2;
        return true;
    };
    auto epi = [&](const Acc& acc, const Unit& u) { epi_part(acc, p, u.pm * 256, (u.pn & 15) * 256, u.pn >> 4); };
    gemm_stream((LAS unsigned char*)shm, Kl, K, get, epi);
}
DI void phase_ffn1(const P& p, char* shm, const char* H, const char* W, bf16_t* hid, bool lat_only) {
    const int nM = lat_only ? NBATCH * SEQ / 256 : NROW / 256, nN = 2 * FF / 256;
    auto get = [&](int i, Unit& u) {
        const long L = (long)i * gridDim.x + blockIdx.x;
        if (L >= nM * nN) return false;
        tile_of((int)L, nM, nN, u.pm, u.pn);
        u.A = H + (size_t)brow_of(u.pm, lat_only) * DM * 2;
        u.B = W + (size_t)u.pn * 256 * DM * 2;
        return true;
    };
    auto epi = [&](const Acc& acc, const Unit& u) { epi_swiglu(acc, brow_of(u.pm, lat_only), u.pn, hid); };
    gemm_stream((LAS unsigned char*)shm, DM, DM, get, epi);
}
DI void phase_inproj1(const P& p, char* shm) {
    const char* H = p.ws + O_H;
    const char* W = p.ws + O_WIN1;
    auto get = [&](int i, Unit& u) {
        const long L = (long)i * gridDim.x + blockIdx.x;
        if (L >= 3072 + 96) return false;
        if (L < 3072) { int pm; tile_of((int)L, 64, 48, pm, u.pn); u.pm = (pm >> 4) * 17 + 1 + (pm & 15); }
        else { const int j = (int)L - 3072; u.pm = (j / 24) * 17; u.pn = 8 + j % 24; }
        const char* hp = H + (size_t)u.pm * 256 * DM * 2;
        const char* wp = W + (size_t)u.pn * 256 * DM * 2;
        const bool tr = u.pn >= 16 && u.pn < 32;
        u.A = tr ? wp : hp; u.B = tr ? hp : wp;
        return true;
    };
    auto epi = [&](const Acc& acc, const Unit& u) {
        const int brow = u.pm * 256, pn = u.pn;
        const int b = u.pm / 17, pt = u.pm % 17;
        const size_t latrow0 = (size_t)b * SEQ + (pt - 1) * 256;
        if (pn < 8) epi_rope256(acc, p, brow, (bf16_t*)(p.ws + O_Q1), latrow0, pn * 256, 1.f);
        else if (pn < 16) epi_rope256(acc, p, brow, (bf16_t*)(p.ws + O_K1), (size_t)brow, (pn - 8) * 256, 0.0625f);
        else if (pn < 32) epi_T<32>(acc, (pn - 16) * 256, brow, (bf16_t*)(p.ws + O_V1T), 4096, nullptr);
        else epi_plain(acc, 0, (bf16_t*)(p.ws + O_G1) + latrow0 * 4096, 4096, (pn - 32) * 256, nullptr);
    };
    gemm_stream((LAS unsigned char*)shm, DM, DM, get, epi);
}

template <int DQK, bool SWA>
DI void attn_item(const P& p, char* shm, int b, int head, int qtile) {
    const int tid = tidx(), wid = tid >> 6, lane = tid & 63, l31 = lane & 31, hh = lane >> 5;
    constexpr int KST = DQK * 2 + 16, VST = 136  , NKC = DQK / 8;
    char* Ks = shm;
    char* Vs = shm + 64 * KST;
    const bf16_t* QA = (const bf16_t*)(p.ws + O_QA);
    const bf16_t* QM = (const bf16_t*)(p.ws + O_QM);
    const bf16_t* KA = (const bf16_t*)(p.ws + O_KA);
    const bf16_t* KN = (const bf16_t*)(p.ws + O_KN);
    const bf16_t* KR = (const bf16_t*)(p.ws + O_KR);
    const bf16_t* VT = (const bf16_t*)(p.ws + (SWA ? O_VAT : O_VMT));
    const int qp0 = qtile == 0 ? 0 : CTXL + (qtile - 1) * 256;
    const int myp = qp0 + wid * 32 + l31;
    const size_t qrow = (size_t)b * PB + myp;
    bf16x8 qf[DQK / 16];
    {
        const bf16_t* qptr = SWA ? QA + qrow * 1024 + head * 128 : QM + qrow * 1536 + head * 192;
#pragma unroll
        for (int s = 0; s < DQK / 16; ++s) qf[s] = *(const bf16x8*)(qptr + 16 * s + 8 * hh);
    }
    int lo = 0, hi = 0;
    if (qtile > 0) {
        if (SWA) { const int q0 = (qtile - 1) * 256; lo = (q0 - 128 < 0 ? 0 : q0 - 128) / 64; hi = (q0 + 384 > SEQ ? SEQ : q0 + 384) / 64; }
        else { lo = 0; hi = SEQ / 64; }
    }
    const int ntiles = 4 + (hi - lo);
    const int kvh = SWA ? head >> 2 : head;
    const int nhv = SWA ? 2 : 8;
    float mrun, lrun;
    if (SWA) { mrun = p.sink[head] * LOG2E; lrun = 1.f; } else { mrun = -1e30f; lrun = 0.f; }
    const float sl2 = (SWA ? 0.08838834764831845f : 0.07216878364870323f) * LOG2E;
    f32x16 oT[4];
#pragma unroll
    for (int v = 0; v < 4; ++v)
#pragma unroll
        for (int r = 0; r < 16; ++r) oT[v][r] = 0.f;
    constexpr int NKL = (64 * NKC) / NTHR;
    bf16x8 kreg[NKL], vreg[2];
    auto kp_of = [&](int t) { return t < 4 ? 64 * t : CTXL + 64 * (lo + t - 4); };
    const int kc0 = tid, kc1 = tid + NTHR;
    const int kld = SWA ? 256 : 1024;
    const int koff0 = (kc0 >> 4) * kld + (kc0 & 15) * 8, koff1 = (kc1 >> 4) * kld + (kc1 & 15) * 8, koff2 = tid * 8;
    const int klds0 = (kc0 >> 4) * KST + (kc0 & 15) * 16, klds1 = (kc1 >> 4) * KST + (kc1 & 15) * 16, klds2 = (tid >> 3) * KST + (16 + (tid & 7)) * 16;
    const int vlds0 = (kc0 >> 3) * VST + (kc0 & 7) * 16, vlds1 = (kc1 >> 3) * VST + (kc1 & 7) * 16;
    auto load_tile = [&](int t) {
        const int kp0 = kp_of(t);
        const size_t ur0 = (size_t)b * PB + kp0;
        if (SWA) {
            const bf16_t* kb = KA + ur0 * 256 + kvh * 128;
            kreg[0] = *(const bf16x8*)(kb + koff0);
            kreg[1] = *(const bf16x8*)(kb + koff1);
        } else {
            const bf16_t* kb = KN + ur0 * 1024 + head * 128;
            kreg[0] = *(const bf16x8*)(kb + koff0);
            kreg[1] = *(const bf16x8*)(kb + koff1);
            kreg[NKL - 1] = *(const bf16x8*)(KR + ur0 * 64 + koff2);
        }
        const bf16_t* vb_ = VT + (((size_t)b * (PB / 64) + (kp0 >> 6)) * (nhv * 128) + kvh * 128) * 64;
        vreg[0] = *(const bf16x8*)(vb_ + kc0 * 8);
        vreg[1] = *(const bf16x8*)(vb_ + kc1 * 8);
    };
    auto store_tile = [&](int t) {
        const int bo = (t & 1) * (64 * KST + 128 * VST);
        *(bf16x8*)(Ks + bo + klds0) = kreg[0];
        *(bf16x8*)(Ks + bo + klds1) = kreg[1];
        if (!SWA) *(bf16x8*)(Ks + bo + klds2) = kreg[NKL - 1];
#pragma unroll
        for (int i = 0; i < 2; ++i) {
            const s16x4 w0 = __builtin_shufflevector(vreg[i], vreg[i], 0, 1, 2, 3), w1 = __builtin_shufflevector(vreg[i], vreg[i], 4, 5, 6, 7);
            char* dstv = Vs + bo + (i ? vlds1 : vlds0);
            *(s16x4*)dstv = w0;
            *(s16x4*)(dstv + 8) = w1;
        }
    };
    constexpr int TB = 64 * KST + 128 * VST;
    load_tile(0);
    store_tile(0);
    load_tile(1);
    __syncthreads();
    for (int t = 0; t < ntiles; ++t) {
        const char* Kb = Ks + (t & 1) * TB;
        const char* Vb = Vs + (t & 1) * TB;
        f32x16 sT[2];
#pragma unroll
        for (int kb = 0; kb < 2; ++kb)
#pragma unroll
            for (int r = 0; r < 16; ++r) sT[kb][r] = 0.f;
        {
            constexpr int NG = DQK / 32;
            const char* kl = Kb + l31 * KST + 16 * hh;
            bf16x8 ka[3][4];
#pragma unroll
            for (int g0 = 0; g0 < 2; ++g0)
#pragma unroll
                for (int i = 0; i < 4; ++i) ka[g0][i] = *(const bf16x8*)(kl + (i & 1) * 32 * KST + 32 * (2 * g0 + (i >> 1)));
            __builtin_amdgcn_s_setprio(1);
#pragma unroll
            for (int g = 0; g < NG; ++g) {
                if (g + 2 < NG) {
#pragma unroll
                    for (int i = 0; i < 4; ++i) ka[(g + 2) % 3][i] = *(const bf16x8*)(kl + (i & 1) * 32 * KST + 32 * (2 * (g + 2) + (i >> 1)));
                }
                __builtin_amdgcn_sched_barrier(0);
#pragma unroll
                for (int i = 0; i < 4; ++i) sT[i & 1] = MFMA32(ka[g % 3][i], qf[2 * g + (i >> 1)], sT[i & 1]);
                __builtin_amdgcn_sched_barrier(0);
            }
            __builtin_amdgcn_s_setprio(0);
        }
        const bool band = SWA && t >= 4;
        const int kl0 = 64 * (lo + t - 4), qs = myp - CTXL;
        float mx = -3.0e38f;
#pragma unroll
        for (int kb = 0; kb < 2; ++kb)
#pragma unroll
            for (int r = 0; r < 16; ++r) {
                if (band) { const int dd = qs - (kl0 + kb * 32 + crow(r, hh)); if (dd > 128 || dd < -128) sT[kb][r] = -3.0e37f; }
                mx = fmaxf(mx, sT[kb][r]);
            }
        mx = fmaxf(mx, __shfl_xor(mx, 32));
        const float cand = fmaxf(mrun, mx * sl2);
        const bool grew = __any(cand - mrun > 8.f);
        const float mn = grew ? cand : mrun;
        const float alpha = __builtin_amdgcn_exp2f(mrun - mn);
        mrun = mn;
        float ls = 0.f;
#pragma unroll
        for (int kb = 0; kb < 2; ++kb)
#pragma unroll
            for (int r = 0; r < 16; ++r) { const float pv = __builtin_amdgcn_exp2f(fmaf(sT[kb][r], sl2, -mn)); sT[kb][r] = pv; ls += pv; }
        ls += __shfl_xor(ls, 32);
        lrun = lrun * alpha + ls;
        if (grew) {
#pragma unroll
            for (int v = 0; v < 4; ++v) oT[v] *= alpha;
        }
        bf16x8 pf[2][2];
#pragma unroll
        for (int kb = 0; kb < 2; ++kb)
#pragma unroll
            for (int s2 = 0; s2 < 2; ++s2)
                pf[kb][s2] = pack8(sT[kb][8 * s2], sT[kb][8 * s2 + 1], sT[kb][8 * s2 + 2], sT[kb][8 * s2 + 3], sT[kb][8 * s2 + 4], sT[kb][8 * s2 + 5], sT[kb][8 * s2 + 6], sT[kb][8 * s2 + 7]);
        if (t + 1 < ntiles) store_tile(t + 1);
        if (t + 2 < ntiles) load_tile(t + 2);
        {
            const char* vl = Vb + l31 * VST + 8 * hh;
            bf16x8 va[2][4];
            auto vfrag = [&](int g, int v) {
                const char* vp = vl + v * 32 * VST + 32 * g;
                const s16x4 vlo = *(const s16x4*)vp, vhi = *(const s16x4*)(vp + 16);
                return (bf16x8)__builtin_shufflevector(vlo, vhi, 0, 1, 2, 3, 4, 5, 6, 7);
            };
#pragma unroll
            for (int v = 0; v < 4; ++v) va[0][v] = vfrag(0, v);
            __builtin_amdgcn_s_setprio(1);
#pragma unroll
            for (int g = 0; g < 4; ++g) {
                if (g + 1 < 4) {
#pragma unroll
                    for (int v = 0; v < 4; ++v) va[(g + 1) & 1][v] = vfrag(g + 1, v);
                }
                __builtin_amdgcn_sched_barrier(0);
#pragma unroll
                for (int v = 0; v < 4; ++v) oT[v] = MFMA32(va[g & 1][v], pf[g >> 1][g & 1], oT[v]);
                __builtin_amdgcn_sched_barrier(0);
            }
            __builtin_amdgcn_s_setprio(0);
        }
        __syncthreads();
    }
    const float inv = 1.f / lrun;
    bf16_t* op = (bf16_t*)(p.ws + O_OCAT) + qrow * DM + (SWA ? 0 : 1024) + head * 128;
#pragma unroll
    for (int v = 0; v < 4; ++v)
#pragma unroll
        for (int g = 0; g < 4; ++g)
            st4(op + v * 32 + 8 * g + 4 * hh, oT[v][4 * g] * inv, oT[v][4 * g + 1] * inv, oT[v][4 * g + 2] * inv, oT[v][4 * g + 3] * inv);
    __syncthreads();
}
DI void phase_attn(const P& p, char* shm) {
    const int total = 512 + 512 + 32 + 32;
    for (int it = blockIdx.x; it < total; it += gridDim.x) {
        const int j0 = it & 511, rnd = (j0 >> 8) & 1, w = j0 & 255, xcd = w & 7, slot = w >> 3;
        const int grp = gridDim.x == 256 ? rnd * 16 + xcd * 2 + (slot >> 4) : j0 >> 4, qt0 = gridDim.x == 256 ? (slot & 15) : (j0 & 15);
        if (it < 512) { attn_item<192, false>(p, shm, grp >> 3, grp & 7, qt0 + 1); }
        else if (it < 1024) { attn_item<128, true>(p, shm, grp >> 3, grp & 7, qt0 + 1); }
        else if (it < 1056) { const int j = it - 1024; attn_item<192, false>(p, shm, j >> 3, j & 7, 0); }
        else { const int j = it - 1056; attn_item<128, true>(p, shm, j >> 3, j & 7, 0); }
    }
}

DI unsigned off_b(unsigned row, unsigned ch) { return 256u * row + 16u * (ch ^ (((row & 3) << 2) | ((row >> 2) & 3))); }
DI void tr_issue4(s16x4 (&r)[4], unsigned a0, unsigned a1, unsigned a2, unsigned a3) {
    asm volatile("ds_read_b64_tr_b16 %0, %4\n\tds_read_b64_tr_b16 %1, %5\n\tds_read_b64_tr_b16 %2, %6\n\tds_read_b64_tr_b16 %3, %7"
                 : "=&v"(r[0]), "=&v"(r[1]), "=&v"(r[2]), "=&v"(r[3]) : "v"(a0), "v"(a1), "v"(a2), "v"(a3) : "memory");
}
template <int N>
DI void tr_wait4(s16x4 (&r)[4]) {
    asm volatile("s_waitcnt lgkmcnt(%4)" : "+v"(r[0]), "+v"(r[1]), "+v"(r[2]), "+v"(r[3]) : "n"(N) : "memory");
}
constexpr int SC_QST = 528  , SC_Q = 0, SC_K = 32 * SC_QST, SC_V = SC_K + 16384, SC_VS = SC_V + 10240, SC_VST = 80, SC_BUF = SC_VS + 10240, SC_X = 2 * SC_BUF  ;
#define PACK16(x, s2) pack8(x[8 * (s2)], x[8 * (s2) + 1], x[8 * (s2) + 2], x[8 * (s2) + 3], x[8 * (s2) + 4], x[8 * (s2) + 5], x[8 * (s2) + 6], x[8 * (s2) + 7])
DI void scan_item(const P& p, char* shm, int item) {
    const int tid = tidx(), wid = __builtin_amdgcn_readfirstlane(tid >> 6);
    const int b = item >> 6, h = (item >> 3) & 7, dir = (item >> 2) & 1, vs = item & 3;
    const int vb = wid & 3, dh = wid >> 2;
    const bf16_t* Q1 = (const bf16_t*)(p.ws + O_Q1);
    const bf16_t* K1 = (const bf16_t*)(p.ws + O_K1);
    const bf16_t* V1T = (const bf16_t*)(p.ws + O_V1T);
    bf16_t* OX = (bf16_t*)(p.ws + (dir ? O_OB : O_OF));
    const float logit = (dir ? p.lb : p.lf)[h];
    const float lg2 = -log1pf(__expf(-logit)) * LOG2E;
    const int nsteps = PB / 32;
    auto p0_of = [&](int s) { return dir == 0 ? 32 * s : (s < 8 ? 224 - 32 * s : PB - 32 - 32 * (s - 8)); };
    const int lane_c = tid & 63, l31_c = lane_c & 31, hh_c = lane_c >> 5;
    const int ld_row0 = tid >> 5, ld_ch32 = tid & 31;
    const int koff = ld_row0 * DM + ld_ch32 * 8;
    const unsigned ldsK0 = (ld_ch32 >> 4) * 8192 + off_b(ld_row0, ld_ch32 & 15), ldsK1 = (ld_ch32 >> 4) * 8192 + off_b(ld_row0 + 16, ld_ch32 & 15);
    const unsigned ldsQ0 = ld_row0 * SC_QST + ld_ch32 * 16, ldsQ1 = ldsQ0 + 16 * SC_QST;
    const int voff = (tid >> 2) * 32 + (tid & 3) * 8;
    const unsigned ldsV = (tid >> 2) * SC_VST + (tid & 3) * 16;
    const unsigned xrow_c = ((l31_c & 3) << 2) | ((l31_c >> 2) & 3);
    const unsigned Lrow = 256u * l31_c + 16u * xrow_c;
    const unsigned Lrd_c = Lrow ^ (16u * hh_c);
    const unsigned q4_c = (lane_c & 15) >> 2, pp_c = lane_c & 3, u_c = 2 * ((lane_c >> 4) & 1) + (pp_c >> 1);
    const unsigned Ltr_c = 256u * (8u * hh_c + q4_c) + 8u * (pp_c & 1) + 64u * q4_c + 16u * (u_c ^ (2u * hh_c));
    const unsigned vrow_c = (vb * 32 + l31_c) * SC_VST;
    const unsigned qrow_c = l31_c * SC_QST + 8u * hh_c;
    const int flane = hh_c * 4 * 4096 + l31_c;
    bf16x8 kq[2], qq[2], vv;
    auto issue_chunk = [&](int s) {
        const int p0 = p0_of(s);
        const bool lat = p0 >= CTXL;
        const bf16_t* kp = K1 + ((size_t)b * PB + p0) * DM + h * 256;
        const bf16_t* qp = Q1 + ((size_t)b * SEQ + (p0 - CTXL)) * DM + h * 256;
        const bf16_t* vp = V1T + (((size_t)b * (PB / 32) + (p0 >> 5)) * 4096 + h * 512 + vs * 128) * 32;
        kq[0] = *(const bf16x8*)(kp + koff);
        kq[1] = *(const bf16x8*)(kp + koff + 16 * DM);
        if (lat) { qq[0] = *(const bf16x8*)(qp + koff); qq[1] = *(const bf16x8*)(qp + koff + 16 * DM); }
        vv = *(const bf16x8*)(vp + voff);
    };
    auto store_chunk = [&](int s) {
        char* buf = shm + (s & 1) * SC_BUF;
        const bool lat = p0_of(s) >= CTXL;
        *(bf16x8*)(buf + SC_K + ldsK0) = kq[0];
        *(bf16x8*)(buf + SC_K + ldsK1) = kq[1];
        if (lat) { *(bf16x8*)(buf + SC_Q + ldsQ0) = qq[0]; *(bf16x8*)(buf + SC_Q + ldsQ1) = qq[1]; }
        *(bf16x8*)(buf + SC_V + ldsV) = vv;
        float f[8];
#pragma unroll
        for (int e = 0; e < 8; ++e) {
            const int j = (tid & 3) * 8 + e;
            f[e] = bf2f((unsigned short)vv[e]) * __builtin_amdgcn_exp2f(lg2 * (float)(dir == 0 ? 31 - j : j));
        }
        *(bf16x8*)(buf + SC_VS + ldsV) = pack8(f[0], f[1], f[2], f[3], f[4], f[5], f[6], f[7]);
    };
    f32x16 st[4];
#pragma unroll
    for (int d = 0; d < 4; ++d)
#pragma unroll
        for (int r = 0; r < 16; ++r) st[d][r] = 0.f;
    f32x16 oprev;
#pragma unroll
    for (int r = 0; r < 16; ++r) oprev[r] = 0.f;
    int pprev = -1;
    const float cdec = __builtin_amdgcn_exp2f(lg2 * 32.f);
    auto flush_prev = [&](int sprev) {
        const float* xp = (const float*)(shm + SC_X + (sprev & 1) * 16384 + vb * 4096) + lane_c * 16;
        bf16_t* ob = OX + ((size_t)b * SEQ + pprev) * 4096 + h * 512 + vs * 128 + vb * 32;
        const __amdgpu_buffer_rsrc_t rs = __builtin_amdgcn_make_buffer_rsrc(ob, 0, 0x7fffffff, 0x00020000);
#pragma unroll
        for (int g = 0; g < 4; ++g) {
            const f32x4 x = *(const f32x4*)(xp + 4 * g);
#pragma unroll
            for (int j = 0; j < 4; ++j)
                __builtin_amdgcn_raw_buffer_store_b16((short)(pk2(oprev[4 * g + j] + x[j], 0.f) & 0xffffu), rs, flane * 2, (j + 8 * g) * 8192, 0);
        }
    };
    float dmask[16];
    float qlane;
    {
#pragma unroll
        for (int r = 0; r < 16; ++r) {
            const int j = crow(r, hh_c);
            const int dd = dir == 0 ? l31_c - j : j - l31_c;
            dmask[r] = dd >= 0 ? __builtin_amdgcn_exp2f(lg2 * (float)dd) : 0.f;
        }
        qlane = __builtin_amdgcn_exp2f(lg2 * (float)(dir == 0 ? 1 + 4 * hh_c : 32 - 4 * hh_c));
    }
    const float lgs = dir == 0 ? lg2 : -lg2;
    issue_chunk(0); store_chunk(0); issue_chunk(1);
    __syncthreads();
    for (int s = 0; s < nsteps; ++s) {
        if (dh == 0 && pprev >= 0) { flush_prev(s - 1); pprev = -1; }
        const int lane = lane_c, l31 = l31_c, hh = hh_c;
        unsigned Lrd = Lrd_c, Ltr = Ltr_c, vrow = vrow_c, qrow = qrow_c;
        asm volatile("" : "+v"(Lrd), "+v"(Ltr), "+v"(vrow), "+v"(qrow));
        const char* buf = shm + (s & 1) * SC_BUF;
        const char* kimg = buf + SC_K + dh * 8192;
        const char* qimg = buf + SC_Q + dh * 256 + qrow;
        const int p0 = p0_of(s);
        if (p0 >= CTXL) {
            f32x16 pT;
#pragma unroll
            for (int r = 0; r < 16; ++r) pT[r] = 0.f;
#pragma unroll
            for (int s8 = 0; s8 < 8; ++s8) {
                const unsigned o = Lrd ^ (32u * s8);
                const bf16x8 a = *(const bf16x8*)(kimg + o);
                const bf16x8 bq = *(const bf16x8*)(qimg + 8 * hh + 32 * s8);
                pT = MFMA32(a, bq, pT);
            }
#pragma unroll
            for (int r = 0; r < 16; ++r) pT[r] *= dmask[r];
            bf16x8 pfr[2];
            pfr[0] = PACK16(pT, 0);
            pfr[1] = PACK16(pT, 1);
            f32x16 o;
#pragma unroll
            for (int r = 0; r < 16; ++r) o[r] = 0.f;
#pragma unroll
            for (int db = 0; db < 4; ++db)
#pragma unroll
                for (int s2 = 0; s2 < 2; ++s2) {
                    const bf16x8 bfrag = PACK16(st[db], s2);
                    const s16x4 qlo = *(const s16x4*)(qimg + db * 64 + 32 * s2), qhi = *(const s16x4*)(qimg + db * 64 + 32 * s2 + 16);
                    const bf16x8 a2 = __builtin_shufflevector(qlo, qhi, 0, 1, 2, 3, 4, 5, 6, 7);
                    o = MFMA32(a2, bfrag, o);
                }
#pragma unroll
            for (int r = 0; r < 16; ++r) o[r] *= qlane * __builtin_amdgcn_exp2f(lgs * (float)((r & 3) + 8 * (r >> 2)));
#pragma unroll
            for (int s2 = 0; s2 < 2; ++s2) {
                const char* vp = buf + SC_V + vrow + 8 * hh + 32 * s2;
                const s16x4 vlo = *(const s16x4*)vp, vhi = *(const s16x4*)(vp + 16);
                const bf16x8 b3 = __builtin_shufflevector(vlo, vhi, 0, 1, 2, 3, 4, 5, 6, 7);
                o = MFMA32(pfr[s2], b3, o);
            }
            if (dh == 1) {
                float* xp = (float*)(shm + SC_X + (s & 1) * 16384 + vb * 4096) + lane * 16;
#pragma unroll
                for (int g = 0; g < 4; ++g) *(f32x4*)(xp + 4 * g) = (f32x4){o[4 * g], o[4 * g + 1], o[4 * g + 2], o[4 * g + 3]};
            } else {
                oprev = o;
                pprev = p0 - CTXL;
            }
            __builtin_amdgcn_sched_barrier(0);
        }
        if (s + 1 < nsteps) store_chunk(s + 1);
        if (s + 2 < nsteps) issue_chunk(s + 2);
        {
            const unsigned ka = (unsigned)(size_t)kimg;
            const char* vsp = buf + SC_VS + vrow + 16 * hh;
            const bf16x8 bv0 = *(const bf16x8*)(vsp), bv1 = *(const bf16x8*)(vsp + 32);
            s16x4 tr[2][4];
            tr_issue4(tr[0], ka + Ltr, ka + 1024u + (Ltr ^ 16u), ka + 4096u + Ltr, ka + 5120u + (Ltr ^ 16u));
#pragma unroll
            for (int db = 0; db < 4; ++db) {
                if (db < 3) {
                    const unsigned cx = 64u * (db + 1);
                    tr_issue4(tr[(db + 1) & 1], ka + (Ltr ^ cx), ka + 1024u + (Ltr ^ (cx + 16u)), ka + 4096u + (Ltr ^ cx), ka + 5120u + (Ltr ^ (cx + 16u)));
                    tr_wait4<4>(tr[db & 1]);
                } else {
                    tr_wait4<0>(tr[db & 1]);
                }
                st[db] *= cdec;
#pragma unroll
                for (int ks = 0; ks < 2; ++ks) {
                    const bf16x8 a = __builtin_shufflevector(tr[db & 1][2 * ks], tr[db & 1][2 * ks + 1], 0, 1, 2, 3, 4, 5, 6, 7);
                    st[db] = MFMA32(a, ks ? bv1 : bv0, st[db]);
                }
            }
        }
        __syncthreads();
    }
    if (dh == 0 && pprev >= 0) flush_prev(nsteps - 1);
    __syncthreads();
}

DI void phase_gn(const P& p, char* shm) {
    const int tix = tidx(), lane = tix & 63, gw = blockIdx.x * (NTHR / 64) + (tix >> 6), nw = gridDim.x * (NTHR / 64);
    const bf16_t* OF = (const bf16_t*)(p.ws + O_OF);
    const bf16_t* OB = (const bf16_t*)(p.ws + O_OB);
    const bf16_t* G1 = (const bf16_t*)(p.ws + O_G1);
    bf16_t* AG = (bf16_t*)(p.ws + O_OF);
    for (int r = gw; r < NBATCH * SEQ; r += nw) {
        const size_t o0 = (size_t)r * 4096 + lane * 8;
#pragma unroll
        for (int hh4 = 0; hh4 < 2; ++hh4) {
            bf16x8 a[4], bq[4], gq[4];
#pragma unroll
            for (int k = 0; k < 4; ++k) {
                const size_t o = o0 + (hh4 * 4 + k) * 512;
                a[k] = __builtin_nontemporal_load((const bf16x8*)(OF + o)); bq[k] = __builtin_nontemporal_load((const bf16x8*)(OB + o)); gq[k] = __builtin_nontemporal_load((const bf16x8*)(G1 + o));
            }
            __builtin_amdgcn_sched_barrier(0);
#pragma unroll
            for (int k = 0; k < 4; ++k) {
                float v[8], s = 0.f;
#pragma unroll
                for (int e = 0; e < 8; ++e) { v[e] = bf2f((unsigned short)a[k][e]) + bf2f((unsigned short)bq[k][e]); s += v[e]; }
                const float mu = wsum(s) * (1.f / 512.f);
                float q = 0.f;
#pragma unroll
                for (int e = 0; e < 8; ++e) { v[e] -= mu; q += v[e] * v[e]; }
                const float rinv = rsqrtf(wsum(q) * (1.f / 512.f) + 1e-6f);
                float y[8];
#pragma unroll
                for (int e = 0; e < 8; ++e) { const float g = bf2f((unsigned short)gq[k][e]); y[e] = silu_f(g) * (v[e] * rinv); }
                *(bf16x8*)(AG + o0 + (hh4 * 4 + k) * 512) = pack8(y[0], y[1], y[2], y[3], y[4], y[5], y[6], y[7]);
                __builtin_amdgcn_sched_barrier(0);
            }
        }
    }
    __syncthreads();
    int base = 0;
    conv_job(p.ret_w_out, nullptr, p.gn_g, (bf16_t*)(p.ws + O_WOUT1), 4096, DM, DM, CK_NAT, base, shm);
    conv_job(p.w_gate + (size_t)DM * FF, p.w_up + (size_t)DM * FF, nullptr, (bf16_t*)(p.ws + O_WGU1), DM, FF, 2 * FF, CK_GU, base, shm);
    conv_job(p.w_down + (size_t)FF * DM, nullptr, nullptr, (bf16_t*)(p.ws + O_WDN1), FF, DM, DM, CK_NAT, base, shm);
}


#define XB_TMO      128
#define XB_XCNT(j)  (256  + 64 * (j))
#define XB_XSUB(j)  (1280 + 64 * (j))
#define XB_XGEN(j)  (2304 + 64 * (j))
#define XB_TOP      3328
#define XB_TOPGEN   3392
#define XCD_BAR_WORDS 3456
#define XB_SPIN_CAP (1u << 18)
DI unsigned xb_ld(unsigned* p) { return __hip_atomic_load(p, __ATOMIC_RELAXED, __HIP_MEMORY_SCOPE_AGENT); }
DI unsigned xb_add(unsigned* p, unsigned v) { return __hip_atomic_fetch_add(p, v, __ATOMIC_RELAXED, __HIP_MEMORY_SCOPE_AGENT); }
DI unsigned xb_xcc_id() { return (unsigned)__builtin_amdgcn_s_getreg((3 << 11) | 20) & 0xFu; }
#define XB_SPIN(cond, bar) do { unsigned _sp = 0; while (cond) { __builtin_amdgcn_s_sleep(1); \
    if ((++_sp & 255u) == 0u) { if (xb_ld(&(bar)[XB_TMO])) break; if (_sp > XB_SPIN_CAP) { atomicAdd(&(bar)[XB_TMO], 1u); break; } } } } while (0)
struct XcdBarrier { unsigned* bar; unsigned x; volatile LAS unsigned* st; };
DI XcdBarrier xcd_barrier_post(unsigned* bar, volatile LAS unsigned* st) {
    XcdBarrier b; b.bar = bar; b.x = xb_xcc_id(); b.st = st;
    if (threadIdx.x == 0) (void)xb_add(&bar[XB_XCNT(b.x)], 1u);
    return b;
}
DI void xcd_barrier_complete(unsigned* bar, unsigned x, unsigned& nloc, unsigned& nx) {
    const unsigned G = gridDim.x * gridDim.y * gridDim.z;
    unsigned sum, cnt, mine, sp = 0u;
    for (;;) {
        sum = 0u; cnt = 0u; mine = 0u;
#pragma unroll
        for (unsigned j = 0; j < 16; ++j) { const unsigned c = xb_ld(&bar[XB_XCNT(j)]); sum += c; cnt += (c > 0u) ? 1u : 0u; mine = (j == x) ? c : mine; }
        if (sum == G) break;
        __builtin_amdgcn_s_sleep(1);
        if ((++sp & 255u) == 0u) { if (xb_ld(&bar[XB_TMO])) break; if (sp > XB_SPIN_CAP) { atomicAdd(&bar[XB_TMO], 1u); break; } }
    }
    nloc = mine > 0u ? mine : 1u; nx = cnt > 0u ? cnt : 1u;
}
DI void xcd_barrier(const XcdBarrier& b) {
    asm volatile("s_waitcnt vmcnt(0)" ::: "memory");
    __syncthreads();
    if (threadIdx.x == 0) {
        unsigned* bar = b.bar;
        __builtin_amdgcn_s_waitcnt(0);
        unsigned nloc = b.st[0], nx = b.st[1];
        if (nloc == 0u) { xcd_barrier_complete(bar, b.x, nloc, nx); b.st[0] = nloc; b.st[1] = nx; }
        const unsigned old = xb_add(&bar[XB_XSUB(b.x)], 1u);
        const unsigned gen = old / nloc;
        if (old + 1u == (gen + 1u) * nloc) {
            __builtin_amdgcn_fence(__ATOMIC_RELEASE, "agent");
            asm volatile("s_waitcnt vmcnt(0)" ::: "memory");
            const unsigned og = xb_add(&bar[XB_TOP], 1u);
            const unsigned tg = og / nx;
            if (og + 1u == (tg + 1u) * nx) xb_add(&bar[XB_TOPGEN], 1u);
            else XB_SPIN(xb_ld(&bar[XB_TOPGEN]) == tg, bar);
            __builtin_amdgcn_fence(__ATOMIC_ACQUIRE, "agent");
            xb_add(&bar[XB_XGEN(b.x)], 1u);
            asm volatile("s_waitcnt vmcnt(0)" ::: "memory");
        } else {
            XB_SPIN(xb_ld(&bar[XB_XGEN(b.x)]) == gen, bar);
            __builtin_amdgcn_fence(__ATOMIC_ACQUIRE, "agent");
            asm volatile("s_waitcnt vmcnt(0)" ::: "memory");
        }
    }
    __syncthreads();
}

#ifndef PHMASK
#define PHMASK 0xFFFFFF
#endif
__global__ void __launch_bounds__(NTHR) fwd_megakernel(P p) {
    extern __shared__ __attribute__((aligned(16))) char shm[];
    cg::grid_group grid = cg::this_grid();
    __shared__ uint4 xb_words;
    if (threadIdx.x == 0) xb_words = make_uint4(0u, 0u, 0u, 0u);
    __syncthreads();
    (void)xcd_barrier_post((unsigned*)(p.ws + O_BAR), (volatile LAS unsigned*)&xb_words);
#define GSYNC() do { XcdBarrier xb_; xb_.bar = (unsigned*)(p.ws + O_BAR); xb_.x = xb_xcc_id(); xb_.st = (volatile LAS unsigned*)&xb_words; xcd_barrier(xb_); } while (0)
#if (PHMASK >> 0) & 1
    phase0(p, shm);
#endif
    grid.sync();
#if (PHMASK >> 1) & 1
    phase_norm(p, 0, 0, true, (bf16_t*)(p.ws + O_H), false, 0, 0, 0);
#endif
    GSYNC();
#if (PHMASK >> 2) & 1
    phase_inproj0(p, shm);
#endif
    GSYNC();
#if (PHMASK >> 3) & 1
    phase_qkvb(p, shm);
#endif
    GSYNC();
#if (PHMASK >> 4) & 1
    phase_attn(p, shm);
#endif
    GSYNC();
#if (PHMASK >> 5) & 1
    phase_gemm_resid(p, shm, p.ws + O_OCAT, p.ws + O_WOUT0, DM, 0, 2, true, true, false);
    phase_gemm_resid_ctx(p, shm, p.ws + O_OCAT, p.ws + O_WOUT0, DM, 8);
#endif
    GSYNC();
#if (PHMASK >> 6) & 1
    phase_norm(p, 0, 1, false, (bf16_t*)(p.ws + O_H), false, 8, 0, 2);
#endif
    GSYNC();
#if (PHMASK >> 7) & 1
    phase_ffn1(p, shm, p.ws + O_H, p.ws + O_WGU0, (bf16_t*)(p.ws + O_HID0), false);
#endif
    GSYNC();
#if (PHMASK >> 8) & 1
    phase_gemm_resid(p, shm, p.ws + O_HID0, p.ws + O_WDN0, FF, 0, 5, false, true, false);
    phase_gemm_resid_ctx(p, shm, p.ws + O_HID0, p.ws + O_WDN0, FF, 11);
#endif
    GSYNC();
#if (PHMASK >> 9) & 1
    phase_norm(p, 1, 0, false, (bf16_t*)(p.ws + O_H), false, 11, 0, 5);
#endif
    GSYNC();
#if (PHMASK >> 10) & 1
    phase_inproj1(p, shm);
#endif
    GSYNC();
#if (PHMASK >> 11) & 1
    for (int it = blockIdx.x; it < 256; it += gridDim.x) {
        const int xcd = it & 7, slot = it >> 3, g = (slot >> 2) * 8 + xcd, vs = slot & 3;
        scan_item(p, shm, gridDim.x == 256 ? g * 4 + vs : it);
    }
#endif
    GSYNC();
#if (PHMASK >> 12) & 1
    phase_gn(p, shm);
#endif
    GSYNC();
#if (PHMASK >> 13) & 1
    phase_gemm_resid(p, shm, p.ws + O_OF, p.ws + O_WOUT1, 4096, 1, 2, false, true, true);
#endif
    GSYNC();
#if (PHMASK >> 14) & 1
    phase_norm(p, 1, 1, false, (bf16_t*)(p.ws + O_H1), true, 0, 0, 0);
#endif
    GSYNC();
#if (PHMASK >> 15) & 1
    phase_ffn1(p, shm, p.ws + O_H1, p.ws + O_WGU1, (bf16_t*)(p.ws + O_HID1), true);
#endif
    GSYNC();
#if (PHMASK >> 16) & 1
    phase_gemm_resid(p, shm, p.ws + O_HID1, p.ws + O_WDN1, FF, 1, 5, false, true, false);
#endif
    GSYNC();
#if (PHMASK >> 17) & 1
    phase_final(p);
#endif
}

extern "C" void kernel_launch(void* const* d_in, const int* in_sizes, int n_in, void* d_out, int out_size, void* d_ws, size_t ws_size,
                              hipStream_t stream) {
    constexpr size_t kDynLds = 2 * 53248 + 2 * 16384 + 1024;
    static int grid_blocks = 0;
    if (!grid_blocks) {
        int dev = 0, cus = 0, per_cu = 0;
        hipGetDevice(&dev);
        hipDeviceGetAttribute(&cus, hipDeviceAttributeMultiprocessorCount, dev);
        hipFuncSetAttribute((const void*)fwd_megakernel, hipFuncAttributeMaxDynamicSharedMemorySize, (int)kDynLds);
        hipOccupancyMaxActiveBlocksPerMultiprocessor(&per_cu, fwd_megakernel, NTHR, kDynLds);
        if (per_cu < 1) per_cu = 1;
        if (per_cu > 1) per_cu = 1;
        grid_blocks = cus * per_cu;
    }
    if (ws_size < WS_NEED) { fprintf(stderr, "workspace too small: %zu < %zu\n", ws_size, WS_NEED); return; }
    P p{};
    const float* const* in = (const float* const*)d_in;
    p.x = in[0]; p.c = in[1]; p.ctx = in[2]; p.c_ctx = in[3]; p.mod_w = in[4]; p.mod_b = in[5]; p.norm_mix_g = in[6]; p.norm_ffn_g = in[7];
    p.w_gate = in[8]; p.w_up = in[9]; p.w_down = in[10]; p.ab_w_in = in[11]; p.ab_w_out = in[12]; p.sink = in[13]; p.q_norm_g = in[14];
    p.w_q_b = in[15]; p.kv_norm_g = in[16]; p.w_kv_b = in[17]; p.ret_w_in = in[18]; p.lf = in[19]; p.lb = in[20]; p.gn_g = in[21];
    p.ret_w_out = in[22]; p.final_g = in[23];
    p.out = (float*)d_out;
    p.ws = (char*)d_ws;
    (void)hipMemsetAsync((char*)d_ws + O_BAR, 0, XCD_BAR_WORDS * sizeof(unsigned), stream);
    void* args[] = {&p};
    hipError_t e = hipLaunchCooperativeKernel((const void*)fwd_megakernel, dim3(grid_blocks), dim3(NTHR), args, kDynLds, stream);
    if (e != hipSuccess) fprintf(stderr, "cooperative launch failed: %s (grid %d)\n", hipGetErrorString(e), grid_blocks);
}
```
